# Optimizing an MI355X kernel written in HIP

```python
import math
import jax, jax.numpy as jnp
from jax import lax
import numpy as np

D_MODEL = 1024
BATCH = 16
SEQ = 2048
DEPTH = 2

N_MIXERS = 2
HEAD_DIM = 64
MEM_LEN = 256
MEM_HEADS = 4
MEM_W = MEM_HEADS * HEAD_DIM
TOK_W = D_MODEL - MEM_W
CHUNK = 128
GMLP_GROUP_DIM = 128
GMLP_GROUPS = TOK_W // GMLP_GROUP_DIM
DIFF_HEADS = TOK_W // (2 * HEAD_DIM)
Q_BLOCK = 128
D_FF = ((8 * D_MODEL // 3) + 127) // 128 * 128
EPS = 1e-6

kernel_name = "hybrid_gmlp_diffattn_macaron_memxattn"


def rms_norm(x, g):
    xf = x.astype(jnp.float32)
    y = xf * lax.rsqrt(jnp.mean(xf * xf, axis=-1, keepdims=True) + EPS)
    return (y * g.astype(jnp.float32)).astype(x.dtype)


def swiglu(h, w_in, w_out):
    gate, up = jnp.split(h @ w_in, 2, axis=-1)
    return (jax.nn.silu(gate) * up) @ w_out


def chunked_gmlp(z, v_gain, w_s, b_s):
    B, S, _ = z.shape
    u, v = jnp.split(jax.nn.gelu(z, approximate=False), 2, axis=-1)
    v = rms_norm(v.reshape(B, S, GMLP_GROUPS, GMLP_GROUP_DIM), v_gain.reshape(GMLP_GROUPS, GMLP_GROUP_DIM))
    v = v.reshape(B, S // CHUNK, CHUNK, GMLP_GROUPS, GMLP_GROUP_DIM)
    ws = w_s * jnp.tril(jnp.ones((CHUNK, CHUNK), dtype=w_s.dtype))
    mixed = jnp.einsum('gts,bnsgc->bntgc', ws, v) + b_s.T[:, :, None]
    return u * mixed.reshape(B, S, TOK_W)


def diff_attention(z, gq, gk, lam_p, subln_g, lambda_init):
    B, S, _ = z.shape
    q, k, v = jnp.split(z, 3, axis=-1)
    q = rms_norm(q.reshape(B, S, DIFF_HEADS, 2, HEAD_DIM), gq)
    k = rms_norm(k.reshape(B, S, DIFF_HEADS, 2, HEAD_DIM), gk)
    vf = v.reshape(B, S, DIFF_HEADS, 2 * HEAD_DIM).astype(jnp.float32)
    lp = lam_p.astype(jnp.float32)
    lam = jnp.exp(jnp.sum(lp[0] * lp[1])) - jnp.exp(jnp.sum(lp[2] * lp[3])) + lambda_init
    scale = HEAD_DIM ** -0.5
    n_blk = S // Q_BLOCK
    qb = q.reshape(B, n_blk, Q_BLOCK, DIFF_HEADS, 2, HEAD_DIM).transpose(1, 0, 2, 3, 4, 5)
    kpos = jnp.arange(S)

    def block(args):
        q_blk, i = args
        s = jnp.einsum('bqhcd,bkhcd->bhcqk', q_blk, k).astype(jnp.float32) * scale
        qpos = i * Q_BLOCK + jnp.arange(Q_BLOCK)
        mask = kpos[None, :] <= qpos[:, None]
        p = jax.nn.softmax(jnp.where(mask, s, -jnp.inf), axis=-1)
        a = p[:, :, 0] - lam * p[:, :, 1]
        return jnp.einsum('bhqk,bkhe->bqhe', a, vf)

    o = lax.map(block, (qb, jnp.arange(n_blk)))
    o = o.transpose(1, 0, 2, 3, 4).reshape(B, S, DIFF_HEADS, 2 * HEAD_DIM)
    o = rms_norm(o, subln_g) * (1.0 - lambda_init)
    return o.reshape(B, S, TOK_W).astype(z.dtype)


def mem_cross_attention(qm, mem_h, w_kv, gq, gk):
    B, S, _ = qm.shape
    L = mem_h.shape[1]
    q = rms_norm(qm.reshape(B, S, MEM_HEADS, HEAD_DIM), gq)
    k, v = jnp.split(mem_h @ w_kv, 2, axis=-1)
    k = rms_norm(k.reshape(B, L, MEM_HEADS, HEAD_DIM), gk)
    v = v.reshape(B, L, MEM_HEADS, HEAD_DIM).astype(jnp.float32)
    s = jnp.einsum('bshd,blhd->bhsl', q, k).astype(jnp.float32) * (HEAD_DIM ** -0.5)
    p = jax.nn.softmax(s, axis=-1)
    o = jnp.einsum('bhsl,blhd->bshd', p, v)
    return o.reshape(B, S, MEM_W).astype(qm.dtype)


def setup_inputs(seed: int = 0) -> dict:
    key = jax.random.key(seed)
    ks = jax.random.split(key, 24)
    n_a = (DEPTH + 1) // 2
    n_b = DEPTH // 2
    f32 = jnp.float32

    def nrm(k, shape, s):
        return jax.random.normal(k, shape, f32) * s

    def gain(k, shape):
        return 1.0 + 0.02 * jax.random.normal(k, shape, f32)

    return {
        "x": jax.random.normal(ks[0], (BATCH, SEQ, D_MODEL), f32),
        "mem": jax.random.normal(ks[1], (BATCH, MEM_LEN, D_MODEL), f32),
        "ffn_norm": gain(ks[2], (DEPTH, 2, D_MODEL)),
        "ffn_w_in": nrm(ks[3], (DEPTH, 2, D_MODEL, 2 * D_FF), D_MODEL ** -0.5),
        "ffn_w_out": nrm(ks[4], (DEPTH, 2, D_FF, D_MODEL), D_FF ** -0.5),
        "mix_norm": gain(ks[5], (DEPTH, D_MODEL)),
        "mem_norm": gain(ks[6], (DEPTH, D_MODEL)),
        "w_mem_kv": nrm(ks[7], (DEPTH, D_MODEL, 2 * MEM_W), D_MODEL ** -0.5),
        "memq_norm": gain(ks[8], (DEPTH, HEAD_DIM)),
        "memk_norm": gain(ks[9], (DEPTH, HEAD_DIM)),
        "w_out": nrm(ks[10], (DEPTH, TOK_W + MEM_W, D_MODEL), (TOK_W + MEM_W) ** -0.5),
        "a_w_in": nrm(ks[11], (n_a, D_MODEL, 2 * TOK_W + MEM_W), D_MODEL ** -0.5),
        "a_v_norm": gain(ks[12], (n_a, TOK_W)),
        "a_w_s": nrm(ks[13], (n_a, GMLP_GROUPS, CHUNK, CHUNK), CHUNK ** -0.5),
        "a_b_s": nrm(ks[14], (n_a, GMLP_GROUPS, CHUNK), 0.02),
        "b_w_in": nrm(ks[15], (n_b, D_MODEL, 3 * TOK_W + MEM_W), D_MODEL ** -0.5),
        "b_q_norm": gain(ks[16], (n_b, HEAD_DIM)),
        "b_k_norm": gain(ks[17], (n_b, HEAD_DIM)),
        "b_lambda": nrm(ks[18], (n_b, 4, HEAD_DIM), 0.1),
        "b_subln": gain(ks[19], (n_b, 2 * HEAD_DIM)),
    }


def reference(x, mem, ffn_norm, ffn_w_in, ffn_w_out, mix_norm, mem_norm, w_mem_kv,
              memq_norm, memk_norm, w_out, a_w_in, a_v_norm, a_w_s, a_b_s,
              b_w_in, b_q_norm, b_k_norm, b_lambda, b_subln):
    for i in range(DEPTH):
        j = i // N_MIXERS
        x = x + 0.5 * swiglu(rms_norm(x, ffn_norm[i, 0]), ffn_w_in[i, 0], ffn_w_out[i, 0])
        h = rms_norm(x, mix_norm[i])
        mem_h = rms_norm(mem, mem_norm[i])
        if i % N_MIXERS == 0:
            z = h @ a_w_in[j]
            tok = chunked_gmlp(z[..., :2 * TOK_W], a_v_norm[j], a_w_s[j], a_b_s[j])
            qm = z[..., 2 * TOK_W:]
        else:
            z = h @ b_w_in[j]
            lambda_init = 0.8 - 0.6 * math.exp(-0.3 * i)
            tok = diff_attention(z[..., :3 * TOK_W], b_q_norm[j], b_k_norm[j], b_lambda[j], b_subln[j], lambda_init)
            qm = z[..., 3 * TOK_W:]
        mo = mem_cross_attention(qm, mem_h, w_mem_kv[i], memq_norm[i], memk_norm[i])
        x = x + jnp.concatenate([tok, mo], axis=-1) @ w_out[i]
        x = x + 0.5 * swiglu(rms_norm(x, ffn_norm[i, 1]), ffn_w_in[i, 1], ffn_w_out[i, 1])
    return x
```

```cpp
#include <hip/hip_runtime.h>
#include <hip/hip_cooperative_groups.h>
#include <cstdio>
#include <cstdint>
namespace cg = cooperative_groups;

#define LAS __attribute__((address_space(3)))
typedef unsigned short bf16_t;
typedef short bf16x8 __attribute__((ext_vector_type(8)));
typedef short s16x4 __attribute__((ext_vector_type(4)));
typedef float f32x2 __attribute__((ext_vector_type(2)));
typedef float f32x4 __attribute__((ext_vector_type(4)));
typedef float f32x16 __attribute__((ext_vector_type(16)));
typedef unsigned u32x2 __attribute__((ext_vector_type(2)));
typedef unsigned u32x4 __attribute__((ext_vector_type(4)));
typedef __bf16 bf16x2_t __attribute__((ext_vector_type(2)));

constexpr int T = 32768, DM = 1024, FF = 2816, SEQ = 2048, NB = 16, MEML = 256, MROWS = NB * MEML, AROWS = T + MROWS;
constexpr int NMIX0 = 1792, NMIX1 = 2560;
constexpr float EPS = 1e-6f;
constexpr float C2 = 0.125f * 1.4426950408889634f;
constexpr float LAMBDA_INIT = 0.35550906759f;

constexpr size_t MiB = 1u << 20;
constexpr size_t SZ_WFFIN = (size_t)2 * FF * DM * 2, SZ_WFFOUT = (size_t)DM * FF * 2;
constexpr size_t WS_WFFIN = 0;
constexpr size_t WS_WFFOUT = WS_WFFIN + 4 * SZ_WFFIN;
constexpr size_t WS_WMIX0 = WS_WFFOUT + 4 * SZ_WFFOUT;
constexpr size_t WS_WMIX1 = WS_WMIX0 + (size_t)2816 * DM * 2;
constexpr size_t WS_WO = WS_WMIX1 + (size_t)NMIX1 * DM * 2;
constexpr size_t WS_XB = WS_WO + (size_t)2 * DM * DM * 2;
constexpr size_t WS_ACT = WS_XB + (size_t)AROWS * DM * 2;
constexpr size_t WS_CAT = WS_ACT + (size_t)T * FF * 2;
constexpr size_t WS_MEMKV = WS_CAT + (size_t)T * DM * 2;
constexpr size_t WS_SSQ = WS_MEMKV + (size_t)MROWS * DM * 2;
constexpr size_t WS_BAR = WS_SSQ + (size_t)AROWS * 16 * 4;
constexpr size_t WS_WSB = WS_BAR + 16384;
constexpr size_t WS_END = WS_WSB + (size_t)6 * 128 * 128 * 2;

constexpr int LDS_BYTES = 147456;

__device__ __forceinline__ unsigned pk_bf16(float lo, float hi) { f32x2 v = {lo, hi}; bf16x2_t b = __builtin_convertvector(v, bf16x2_t); return __builtin_bit_cast(unsigned, b); }
__device__ __forceinline__ float bf_lo(unsigned u) { return __builtin_bit_cast(float, u << 16); }
__device__ __forceinline__ float bf_hi(unsigned u) { return __builtin_bit_cast(float, u & 0xffff0000u); }
__device__ __forceinline__ float wave_sum(float v) {
#pragma unroll
    for (int o = 1; o < 64; o <<= 1) v += __shfl_xor(v, o);
    return v;
}
__device__ __forceinline__ float fast_exp2(float x) { return __builtin_amdgcn_exp2f(x); }
__device__ __forceinline__ float fast_rcp(float x) { return __builtin_amdgcn_rcpf(x); }
__device__ __forceinline__ f32x2 gelu_pk(f32x2 v) {
    const f32x2 av = __builtin_elementwise_abs(v), d = av * 0.2316418882f + 1.0f;
    f32x2 t; t.x = __builtin_amdgcn_rcpf(d.x); t.y = __builtin_amdgcn_rcpf(d.y);
    f32x2 q = t * 0.5307027145f + (-0.7265760135f); q = q * t + 0.7107068705f; q = q * t + (-0.142248368f); q = q * t + 0.127414796f; q = q * t;
    const f32x2 s = (v * v) * (-0.72134752044f);
    f32x2 e; e.x = __builtin_amdgcn_exp2f(s.x); e.y = __builtin_amdgcn_exp2f(s.y);
    const f32x2 m = v * (q * e), r = v - m;
    f32x2 o; o.x = v.x < 0.f ? m.x : r.x; o.y = v.y < 0.f ? m.y : r.y; return o;
}
__device__ __forceinline__ f32x4 gelu4(f32x4 v) { f32x2 a = gelu_pk((f32x2){v[0], v[1]}), b = gelu_pk((f32x2){v[2], v[3]}); return (f32x4){a.x, a.y, b.x, b.y}; }
__device__ __forceinline__ float silu(float g) { return g * fast_rcp(1.f + fast_exp2(-1.4426950408889634f * g)); }
__device__ __forceinline__ float row_rstd(const float* ssq, int row) {
    const f32x4 s = *(const f32x4*)(ssq + (size_t)row * 4);
    return rsqrtf(((s.x + s.y) + (s.z + s.w)) * (1.f / DM) + EPS);
}

__device__ __forceinline__ void rstd_finish(const f32x4& raw0, const f32x4& raw1, float& rn0, float& rn1) {
    rn0 = rsqrtf(((raw0.x + raw0.y) + (raw0.z + raw0.w)) * (1.f / DM) + EPS); rn1 = rsqrtf(((raw1.x + raw1.y) + (raw1.z + raw1.w)) * (1.f / DM) + EPS);
    asm volatile("" :: "v"(rn0), "v"(rn1) : "memory");
}

namespace pg8 {
constexpr int BM = 256, BK = 64, HALF = 128, HTB = HALF * BK * 2, STAGE_BYTES = 8 * HTB, NXCD = 8, WGM = 8;
__host__ __device__ __forceinline__ int lds_byte(int r, int c) { const int st = (r >> 4) * 2 + (c >> 5), rr = r & 15, cc = c & 31, ob = rr * 64 + cc * 2; return st * 1024 + (ob ^ (((ob >> 9) & 1) << 5)); }
__host__ __device__ __forceinline__ void stage_rc(int b, int& R, int& C) { const int st = b / 1024, sb = b % 1024, swz = sb ^ (((sb >> 9) & 1) << 5); R = (st >> 1) * 16 + swz / 64; C = (st & 1) * 32 + (swz % 64) / 2; }
__host__ __device__ __forceinline__ int perm32(int rho) { const int n = rho >> 4, i = rho & 15; return 8 * (i >> 2) + 4 * n + (i & 3); }

struct Unit { int pm, pn; };
struct Gemm { const bf16_t* A; const bf16_t* Bt; int M, N, K; };

struct Order {
    int nM, nN, nwg, G, c, exM, total;
    __device__ void init(int M, int N, int G_, int c_, int exM_ = 0, int exN_ = 0) { nM = M / BM; nN = N / BM; nwg = nM * nN; G = G_; c = c_; exM = exM_; total = nwg + exM_ * exN_; }
    __device__ bool next(int i, Unit& u) const {
        const long L = (long)i * G + c; if (L >= total) return false;
        if (L >= nwg) { const int e = (int)L - nwg; u.pm = nM + e % exM; u.pn = nN + e / exM; return true; }
        int wgid = (int)L; { const int q = nwg / NXCD, r = nwg % NXCD, xcd = wgid % NXCD, off = wgid / NXCD; wgid = (xcd < r ? xcd * (q + 1) : r * (q + 1) + (xcd - r) * q) + off; }
        const int nig = WGM * nN, gid = wgid / nig, fm = gid * WGM, gsz = (nM - fm) < WGM ? (nM - fm) : WGM;
        u.pm = fm + ((wgid % nig) % gsz); u.pn = (wgid % nig) / gsz; return true;
    }
};


struct EpiSwiglu {
    static constexpr bool NEEDS_RSTD = true, EARLY_RSTD = true;
    bf16_t* O; const float* ssq;
    __device__ __forceinline__ void operator()(const f32x4 (&acc)[2][2][4][2], const Unit& u, int wr, int wc, int fr, int fq, float rp0, float rp1, const f32x4& raw0, const f32x4& raw1, float& rn0, float& rn1) const {
        const int row0 = u.pm * BM + wr * 64 + fr, col0 = u.pn * 128 + wc * 32 + 8 * fq;
        float rs[8];
#pragma unroll
        for (int k = 0; k < 8; ++k) rs[k] = __shfl((k >> 2) ? rp1 : rp0, fr + 16 * (k & 3));
#pragma unroll
        for (int ai = 0; ai < 2; ++ai)
#pragma unroll
            for (int m = 0; m < 4; ++m) {
                const int row = row0 + ai * HALF + m * 16; const float r = rs[ai * 4 + m];
                const float c1 = -1.4426950408889634f * r, r2 = r * r;
                const f32x4 ga = acc[ai][0][m][0], gb = acc[ai][0][m][1];
                const f32x4 ta = ga * c1, tb = gb * c1;
                f32x4 ea, eb;
#pragma unroll
                for (int j = 0; j < 4; ++j) { ea[j] = fast_exp2(ta[j]); eb[j] = fast_exp2(tb[j]); }
                const f32x4 da = ea + 1.f, db = eb + 1.f;
                f32x4 qa, qb;
#pragma unroll
                for (int j = 0; j < 4; ++j) { qa[j] = fast_rcp(da[j]); qb[j] = fast_rcp(db[j]); }
                const f32x4 oa = ((ga * acc[ai][1][m][0]) * r2) * qa, ob = ((gb * acc[ai][1][m][1]) * r2) * qb;
                u32x4 w;
                w.x = pk_bf16(oa[0], oa[1]); w.y = pk_bf16(oa[2], oa[3]); w.z = pk_bf16(ob[0], ob[1]); w.w = pk_bf16(ob[2], ob[3]);
                if (ai == 0 && m == 0) rstd_finish(raw0, raw1, rn0, rn1);
                *(u32x4*)(O + (size_t)row * FF + col0) = w;
            }
    }
};
struct EpiResid {
    static constexpr bool NEEDS_RSTD = false, EARLY_RSTD = false;
    bf16_t* xb; float* outf; float* ssq; float alpha; LAS float* red; int tid;
    __device__ __forceinline__ void operator()(const f32x4 (&acc)[2][2][4][2], const Unit& u, int wr, int wc, int fr, int fq, float, float, const f32x4&, const f32x4&, float&, float&) const {
        const int row0 = u.pm * BM + wr * 64 + fr, col0 = u.pn * BM + wc * 32 + 8 * fq;
        const size_t off0 = (size_t)row0 * DM + col0;
        u32x4 xv[3][2];
#define RESID_LOAD(slot, k) do { const bf16_t* _p = xb + off0 + (size_t)(((k) >> 2) * HALF + ((k) & 3) * 16) * DM; \
        xv[slot][0] = *(const u32x4*)(_p); xv[slot][1] = *(const u32x4*)(_p + HALF); } while (0)
        RESID_LOAD(0, 0); RESID_LOAD(1, 1);
#pragma unroll
        for (int k = 0; k < 8; ++k) {
            const int ai = k >> 2, m = k & 3;
            if (k + 2 < 8) RESID_LOAD((k + 2) % 3, k + 2);
            const size_t off = off0 + (size_t)(ai * HALF + m * 16) * DM; float sq = 0.f;
#pragma unroll
            for (int bj = 0; bj < 2; ++bj) {
                const u32x4 xr = xv[k % 3][bj];
                f32x4 x0 = {bf_lo(xr.x), bf_hi(xr.x), bf_lo(xr.y), bf_hi(xr.y)}, x1 = {bf_lo(xr.z), bf_hi(xr.z), bf_lo(xr.w), bf_hi(xr.w)};
                x0 = x0 + acc[ai][bj][m][0] * alpha; x1 = x1 + acc[ai][bj][m][1] * alpha;
                if (outf) { *(f32x4*)(outf + off + bj * HALF) = x0; *(f32x4*)(outf + off + bj * HALF + 4) = x1; }
                else {
                    u32x4 w; w.x = pk_bf16(x0[0], x0[1]); w.y = pk_bf16(x0[2], x0[3]); w.z = pk_bf16(x1[0], x1[1]); w.w = pk_bf16(x1[2], x1[3]);
                    *(u32x4*)(xb + off + bj * HALF) = w;
                    const f32x4 q = x0 * x0 + x1 * x1; sq += (q[0] + q[1]) + (q[2] + q[3]);
                }
            }
            if (!outf) {
                sq += __shfl_xor(sq, 16); sq += __shfl_xor(sq, 32);
                if (fq == 0) red[(ai * HALF + wr * 64 + m * 16 + fr) * 4 + wc] = sq;
            }
        }
#undef RESID_LOAD
        if (!outf) {
            __syncthreads();
            const int t = tid;
            if (t < BM) { const f32x4 s = *(const LAS f32x4*)(red + t * 4); ssq[(size_t)(u.pm * BM + t) * 4 + u.pn] = (s.x + s.y) + (s.z + s.w); }
        }
    }
};
struct EpiZ {
    static constexpr bool NEEDS_RSTD = true, EARLY_RSTD = false;
    bf16_t* Z; int ldz; int layer; int nmain; const float* ssq; bf16_t* KV; const float* gq; const float* gk; const float* gmq; const float* gmk;
    __device__ __forceinline__ void operator()(const f32x4 (&acc)[2][2][4][2], const Unit& u, int wr, int wc, int fr, int fq, float rp0, float rp1, const f32x4& raw0, const f32x4& raw1, float& rn0, float& rn1) const {
        const int arow0 = u.pm * BM + wr * 64 + fr, pn = u.pn;
        bf16_t* base; int ld;
        if (pn < nmain) { base = Z + (size_t)arow0 * ldz + pn * BM; ld = ldz; }
        else { base = KV + (size_t)(arow0 - T) * DM + (pn - nmain) * BM; ld = DM; }
        base += wc * 64 + 8 * fq;
        int mode = 0; const float* gain = gmq; float scale = 1.f;
        if (layer == 0) { if (pn < 6) mode = 1; else if (pn == 6) { mode = 2; scale = C2; } else if (pn == 7) { mode = 2; gain = gmk; } else if (pn == 9) { mode = 2; gain = gmk + 64; } }
        else { if (pn < 3) { mode = 2; gain = gq; scale = C2; } else if (pn < 6) { mode = 2; gain = gk; } else if (pn == 9) { mode = 2; gain = gmq + 64; scale = C2; } }
        if (mode == 2) {
            f32x4 g[2][2];
#pragma unroll
            for (int bj = 0; bj < 2; ++bj)
#pragma unroll
                for (int n = 0; n < 2; ++n) g[bj][n] = *(const f32x4*)(gain + bj * 32 + 8 * fq + 4 * n) * scale;
#pragma unroll
            for (int ai = 0; ai < 2; ++ai) {
                float rs[4];
#pragma unroll
                for (int k = 0; k < 4; ++k) rs[k] = __shfl(ai ? rp1 : rp0, fr + 16 * k);
#pragma unroll
                for (int m = 0; m < 4; ++m) {
                    const int roff = ai * HALF + m * 16; const float r = rs[m];
                    const f32x4 v00 = acc[ai][0][m][0] * r, v01 = acc[ai][0][m][1] * r, v10 = acc[ai][1][m][0] * r, v11 = acc[ai][1][m][1] * r;
                    const f32x4 sq4 = (v00 * v00 + v01 * v01) + (v10 * v10 + v11 * v11);
                    float ss = (sq4[0] + sq4[1]) + (sq4[2] + sq4[3]);
                    ss += __shfl_xor(ss, 16); ss += __shfl_xor(ss, 32);
                    const float rr = rsqrtf(ss * (1.f / 64.f) + EPS);
                    const f32x4 o00 = v00 * rr * g[0][0], o01 = v01 * rr * g[0][1], o10 = v10 * rr * g[1][0], o11 = v11 * rr * g[1][1];
                    u32x4 w0, w1;
                    w0.x = pk_bf16(o00[0], o00[1]); w0.y = pk_bf16(o00[2], o00[3]); w0.z = pk_bf16(o01[0], o01[1]); w0.w = pk_bf16(o01[2], o01[3]);
                    w1.x = pk_bf16(o10[0], o10[1]); w1.y = pk_bf16(o10[2], o10[3]); w1.z = pk_bf16(o11[0], o11[1]); w1.w = pk_bf16(o11[2], o11[3]);
                    *(u32x4*)(base + (size_t)roff * ld) = w0; *(u32x4*)(base + (size_t)roff * ld + 32) = w1;
                }
            }
        } else {
            const bool gel = mode == 1;
#pragma unroll
            for (int ai = 0; ai < 2; ++ai) {
                float rs[4];
#pragma unroll
                for (int k = 0; k < 4; ++k) rs[k] = __shfl(ai ? rp1 : rp0, fr + 16 * k);
#pragma unroll
                for (int m = 0; m < 4; ++m) {
                    const int roff = ai * HALF + m * 16; const float r = rs[m];
#pragma unroll
                    for (int bj = 0; bj < 2; ++bj) {
                        f32x4 v0 = acc[ai][bj][m][0] * r, v1 = acc[ai][bj][m][1] * r;
                        if (gel) { v0 = gelu4(v0); v1 = gelu4(v1); }
                        u32x4 w; w.x = pk_bf16(v0[0], v0[1]); w.y = pk_bf16(v0[2], v0[3]); w.z = pk_bf16(v1[0], v1[1]); w.w = pk_bf16(v1[2], v1[3]);
                        *(u32x4*)(base + (size_t)roff * ld + bj * 32) = w;
                    }
                }
            }
        }
    }
};

template <class Epi>
__device__ __forceinline__ void gemm_phase(LAS unsigned char* lds, const Gemm g, const Order& S, const Epi& E, const int tid) {
    const int wid = __builtin_amdgcn_readfirstlane(tid >> 6), lane = tid & 63, wr = wid >> 2, wc = wid & 3, fr = lane & 15, fq = lane >> 4;
    const int K = g.K, nt = K / BK;
    unsigned voffA[2], voffB[2];
#pragma unroll
    for (int i = 0; i < 2; ++i) { int R, C; stage_rc(tid * 16 + i * 8192, R, C); const int Rb = (R & ~31) + perm32(R & 31);
        voffA[i] = (unsigned)(R * K + C) * 2u; voffB[i] = (unsigned)(Rb * K + C) * 2u; }
    const size_t kstep = (size_t)(BK * 2);
    const size_t hstep = (size_t)HALF * K * 2;
    const size_t tstep = 2 * hstep;
    const unsigned ldsw = (unsigned)wid * 1024u;
    const int aoff = lds_byte(wr * 64 + fr, fq * 8), boff = lds_byte(wc * 32 + fr, fq * 8);
#define PG8_SA(b, h) (((b) * 2 + (h)) * HTB)
#define PG8_SB(b, h) ((4 + (b) * 2 + (h)) * HTB)
#define PG8_STAGE(bufoff, gbase, voff) do { _Pragma("unroll") for (int _i = 0; _i < 2; ++_i) \
        __builtin_amdgcn_global_load_lds((const unsigned*)((const char*)(gbase) + (voff)[_i]), (LAS unsigned*)(lds + (bufoff) + ldsw + _i * 8192), 16, 0, 0); } while (0)
#define PG8_LDA(dst, b, h) do { _Pragma("unroll") for (int m = 0; m < 4; ++m) _Pragma("unroll") for (int k = 0; k < 2; ++k) dst[m][k] = *(const LAS bf16x8*)(lds + PG8_SA(b, h) + aoff + m * 2048 + k * 1024); } while (0)
#define PG8_LDB(dst, b, h) do { _Pragma("unroll") for (int n = 0; n < 2; ++n) _Pragma("unroll") for (int k = 0; k < 2; ++k) dst[n][k] = *(const LAS bf16x8*)(lds + PG8_SB(b, h) + boff + n * 2048 + k * 1024); } while (0)
#define PG8_MMA(ai, bj, At, Bt) do { __builtin_amdgcn_s_setprio(1); _Pragma("unroll") for (int m = 0; m < 4; ++m) _Pragma("unroll") for (int n = 0; n < 2; ++n) _Pragma("unroll") for (int k = 0; k < 2; ++k) \
        acc[ai][bj][m][n] = __builtin_amdgcn_mfma_f32_16x16x32_bf16(Bt[n][k], At[m][k], acc[ai][bj][m][n], 0, 0, 0); __builtin_amdgcn_s_setprio(0); } while (0)
#define PG8_WAIT_V(n) asm volatile("s_waitcnt vmcnt(" #n ")" ::: "memory")
#define PG8_WAIT_L(n) asm volatile("s_waitcnt lgkmcnt(" #n ")" ::: "memory")
#define PG8_BAR __builtin_amdgcn_s_barrier()
#define PG8_SCHED __builtin_amdgcn_sched_barrier(0)
    Unit cur, nxt; int ui = 0;
    if (!S.next(0, cur)) return;
    float rp0 = 0.f, rp1 = 0.f;
    if constexpr (Epi::NEEDS_RSTD) { const int rr = cur.pm * BM + wr * 64 + fr + 16 * fq; rp0 = row_rstd(E.ssq, rr); rp1 = row_rstd(E.ssq, rr + HALF); }
    f32x4 acc[2][2][4][2];
#pragma unroll
    for (int a = 0; a < 2; ++a)
#pragma unroll
        for (int b = 0; b < 2; ++b)
#pragma unroll
            for (int m = 0; m < 4; ++m)
#pragma unroll
                for (int n = 0; n < 2; ++n) acc[a][b][m][n] = (f32x4){0.f, 0.f, 0.f, 0.f};
    bf16x8 At[4][2], B0[2][2], B1[2][2];
    const char* cA = (const char*)g.A + (size_t)cur.pm * tstep; const char* cB = (const char*)g.Bt + (size_t)cur.pn * tstep;
    PG8_STAGE(PG8_SB(0, 0), cB, voffB); PG8_STAGE(PG8_SB(0, 1), cB + hstep, voffB); PG8_STAGE(PG8_SA(0, 0), cA, voffA); PG8_STAGE(PG8_SA(0, 1), cA + hstep, voffA);
    if (wr == 1) PG8_BAR;
    PG8_WAIT_V(2); PG8_BAR;
    PG8_STAGE(PG8_SB(1, 0), cB + kstep, voffB); PG8_STAGE(PG8_SA(1, 0), cA + kstep, voffA); PG8_STAGE(PG8_SB(1, 1), cB + hstep + kstep, voffB);
    PG8_WAIT_V(6); PG8_BAR;
    for (;;) {
        const bool has_next = S.next(ui + 1, nxt);
        const char* nA = has_next ? (const char*)g.A + (size_t)nxt.pm * tstep : cA; const char* nB = has_next ? (const char*)g.Bt + (size_t)nxt.pn * tstep : cB;
        for (int t = 0; t < nt; t += 2) {
            const bool last = (t == nt - 2);
            const char* a1 = cA + (size_t)(t + 1) * kstep;
            const char* a2 = last ? nA : cA + (size_t)(t + 2) * kstep; const char* b2 = last ? nB : cB + (size_t)(t + 2) * kstep;
            const char* a3 = a2 + kstep; const char* b3 = b2 + kstep;
            PG8_LDB(B0, 0, 0); PG8_LDB(B1, 0, 1); PG8_SCHED; PG8_LDA(At, 0, 0); PG8_STAGE(PG8_SA(1, 1), a1 + hstep, voffA);
            PG8_WAIT_V(8); PG8_WAIT_L(0); PG8_BAR; PG8_MMA(0, 0, At, B0); PG8_MMA(0, 1, At, B1); PG8_BAR; PG8_SCHED;
            PG8_LDA(At, 0, 1); PG8_STAGE(PG8_SB(0, 0), b2, voffB); PG8_STAGE(PG8_SB(0, 1), b2 + hstep, voffB); PG8_STAGE(PG8_SA(0, 0), a2, voffA);
            PG8_WAIT_V(8); PG8_WAIT_L(0); PG8_BAR; PG8_MMA(1, 0, At, B0); PG8_MMA(1, 1, At, B1); PG8_BAR; PG8_SCHED;
            PG8_LDB(B0, 1, 0); PG8_LDB(B1, 1, 1); PG8_SCHED; PG8_LDA(At, 1, 0); PG8_STAGE(PG8_SA(0, 1), a2 + hstep, voffA);
            PG8_WAIT_V(8); PG8_WAIT_L(0); PG8_BAR; PG8_MMA(0, 0, At, B0); PG8_MMA(0, 1, At, B1); PG8_BAR; PG8_SCHED;
            PG8_LDA(At, 1, 1); PG8_STAGE(PG8_SB(1, 0), b3, voffB); PG8_STAGE(PG8_SB(1, 1), b3 + hstep, voffB); PG8_STAGE(PG8_SA(1, 0), a3, voffA);
            PG8_WAIT_V(8); PG8_WAIT_L(0); PG8_BAR; PG8_MMA(1, 0, At, B0); PG8_MMA(1, 1, At, B1); PG8_BAR; PG8_SCHED;
        }
        f32x4 raw0, raw1;
        if constexpr (Epi::NEEDS_RSTD) { const int rr = (has_next ? nxt.pm : cur.pm) * BM + wr * 64 + fr + 16 * fq;
            raw0 = *(const f32x4*)(E.ssq + (size_t)rr * 4); raw1 = *(const f32x4*)(E.ssq + (size_t)(rr + HALF) * 4); }
        if (wr == 0) PG8_BAR;
        float rn0 = 0.f, rn1 = 0.f;
        E(acc, cur, wr, wc, fr, fq, rp0, rp1, raw0, raw1, rn0, rn1);
        if constexpr (Epi::NEEDS_RSTD && !Epi::EARLY_RSTD) rstd_finish(raw0, raw1, rn0, rn1);
        rp0 = rn0; rp1 = rn1;
        if (!has_next) break;
#pragma unroll
        for (int a = 0; a < 2; ++a)
#pragma unroll
            for (int b = 0; b < 2; ++b)
#pragma unroll
                for (int m = 0; m < 4; ++m)
#pragma unroll
                    for (int n = 0; n < 2; ++n) acc[a][b][m][n] = (f32x4){0.f, 0.f, 0.f, 0.f};
        cur = nxt; cA = nA; cB = nB; ++ui;
        if (wr == 1) PG8_BAR;
    }
    PG8_WAIT_V(0);
    PG8_BAR;
#undef PG8_SA
#undef PG8_SB
#undef PG8_STAGE
#undef PG8_LDA
#undef PG8_LDB
#undef PG8_MMA
#undef PG8_WAIT_V
#undef PG8_WAIT_L
#undef PG8_BAR
#undef PG8_SCHED
}
}

struct TrDesc { const float* W; int K, N; bf16_t* WT; const float* gain; int k0, n0, drow0; };
__device__ __forceinline__ void tr_loads(const TrDesc& d, float (&wv)[32], int lane) {
#pragma unroll
    for (int i = 0; i < 32; ++i) wv[i] = d.W[(size_t)(d.k0 + 2 * i + (lane >> 5)) * d.N + d.n0 + (lane & 31)];
}
__device__ __forceinline__ void tr_finish(const TrDesc& d, float (&wv)[32], LAS float* scr, int lane) {
    if (d.gain) {
#pragma unroll
        for (int i = 0; i < 32; ++i) wv[i] *= d.gain[d.k0 + 2 * i + (lane >> 5)];
    }
#pragma unroll
    for (int i = 0; i < 32; ++i) scr[(2 * i + (lane >> 5)) * 33 + (lane & 31)] = wv[i];
    asm volatile("s_waitcnt lgkmcnt(0)" ::: "memory");
    const int c = lane & 7;
#pragma unroll
    for (int j = 0; j < 4; ++j) { const int n = (lane >> 3) + 8 * j; const LAS float* s = scr + (8 * c) * 33 + n;
        u32x4 o; o.x = pk_bf16(s[0 * 33], s[1 * 33]); o.y = pk_bf16(s[2 * 33], s[3 * 33]); o.z = pk_bf16(s[4 * 33], s[5 * 33]); o.w = pk_bf16(s[6 * 33], s[7 * 33]);
        *(u32x4*)(d.WT + (size_t)(d.drow0 + n) * d.K + d.k0 + 8 * c) = o; }
    asm volatile("s_waitcnt lgkmcnt(0)" ::: "memory");
}
__device__ __forceinline__ void row_to_bf16(const float* xrow, bf16_t* orow, float* ssqrow, int lane) {
    const f32x4* xr = (const f32x4*)xrow + lane;
    f32x4 v[4]; float s = 0.f;
#pragma unroll
    for (int j = 0; j < 4; ++j) { v[j] = xr[64 * j]; s += (v[j].x * v[j].x + v[j].y * v[j].y) + (v[j].z * v[j].z + v[j].w * v[j].w); }
    s = wave_sum(s);
    u32x2* o8 = (u32x2*)orow + lane;
#pragma unroll
    for (int j = 0; j < 4; ++j) { u32x2 w; w.x = pk_bf16(v[j].x, v[j].y); w.y = pk_bf16(v[j].z, v[j].w); o8[64 * j] = w; }
    if (lane < 16) ssqrow[lane] = lane == 0 ? s : 0.f;
}

struct Params { const float* in[20]; float* out; unsigned char* ws; };
__device__ __forceinline__ int mixrow(int n0) { const int l = n0 & 255; return (n0 & ~255) + ((l >> 5) & 1) * 128 + (l >> 6) * 32; }

__device__ __forceinline__ void prologue(const Params& p, LAS unsigned char* lds, int gw, int NGW, int wave, int lane) {
    LAS float* scr = (LAS float*)(lds + wave * 16384);
    unsigned char* ws = p.ws;
    constexpr int I_FFIN = 16 * 176, I_FFOUT = 44 * 32, I_MIX0 = 16 * 56, I_KV = 16 * 16, I_MIX1 = 16 * 80, I_WO = 16 * 32;
    constexpr int C0 = 4 * I_FFIN, C1 = C0 + 4 * I_FFOUT, C2_ = C1 + I_MIX0, C3 = C2_ + 2 * I_KV, C4 = C3 + I_MIX1, C5 = C4 + 2 * I_WO;
    for (int it0 = gw; it0 < C5; it0 += 2 * NGW) {
        TrDesc ds[2];
#pragma unroll
        for (int q = 0; q < 2; ++q) {
            const int it = min(it0 + q * NGW, C5 - 1); TrDesc& d = ds[q];
            if (it < C0) {
                const int mat = it / I_FFIN, r = it % I_FFIN, kb = r / 176, nb = r % 176, n0 = nb * 32;
                const int j = n0 < FF ? n0 : n0 - FF; const int drow0 = (j >> 7) * 256 + (n0 < FF ? 0 : 128) + (j & 127);
                d = TrDesc{p.in[3] + (size_t)mat * DM * 2 * FF, DM, 2 * FF, (bf16_t*)(ws + WS_WFFIN + mat * SZ_WFFIN), p.in[2] + mat * DM, kb * 64, n0, drow0};
            } else if (it < C1) {
                const int r0 = it - C0, mat = r0 / I_FFOUT, r = r0 % I_FFOUT, kb = r / 32, nb = r % 32;
                d = TrDesc{p.in[4] + (size_t)mat * FF * DM, FF, DM, (bf16_t*)(ws + WS_WFFOUT + mat * SZ_WFFOUT), nullptr, kb * 64, nb * 32, nb * 32};
            } else if (it < C2_) {
                const int r = it - C1, kb = r / 56, nb = r % 56;
                d = TrDesc{p.in[11], DM, NMIX0, (bf16_t*)(ws + WS_WMIX0), p.in[5], kb * 64, nb * 32, mixrow(nb * 32)};
            } else if (it < C3) {
                const int r0 = it - C2_, l = r0 / I_KV, r = r0 % I_KV, kb = r / 16, nb = r % 16;
                d = TrDesc{p.in[7] + (size_t)l * DM * 512, DM, 512, (bf16_t*)(ws + WS_WMIX0), p.in[6] + l * DM, kb * 64, nb * 32, NMIX0 + l * 512 + mixrow(nb * 32)};
            } else if (it < C4) {
                const int r = it - C3, kb = r / 80, nb = r % 80;
                d = TrDesc{p.in[15], DM, NMIX1, (bf16_t*)(ws + WS_WMIX1), p.in[5] + DM, kb * 64, nb * 32, mixrow(nb * 32)};
            } else {
                const int r0 = it - C4, l = r0 / I_WO, r = r0 % I_WO, kb = r / 32, nb = r % 32;
                d = TrDesc{p.in[10] + (size_t)l * DM * DM, DM, DM, (bf16_t*)(ws + WS_WO + (size_t)l * DM * DM * 2), nullptr, kb * 64, nb * 32, nb * 32};
            }
        }
        float wa[32], wb[32];
        tr_loads(ds[0], wa, lane); tr_loads(ds[1], wb, lane);
        tr_finish(ds[0], wa, scr, lane); tr_finish(ds[1], wb, scr, lane);
    }
    {
        const int gt = gw * 64 + lane;
        if (gt < 6 * 128 * 16) {
            const int row = gt >> 4, seg = gt & 15, t = row & 127;
            const float* s = p.in[13] + (size_t)row * 128 + seg * 8;
            f32x4 a = *(const f32x4*)s, b = *(const f32x4*)(s + 4);
#pragma unroll
            for (int j = 0; j < 4; ++j) { if (seg * 8 + j > t) a[j] = 0.f; if (seg * 8 + 4 + j > t) b[j] = 0.f; }
            u32x4 o; o.x = pk_bf16(a[0], a[1]); o.y = pk_bf16(a[2], a[3]); o.z = pk_bf16(b[0], b[1]); o.w = pk_bf16(b[2], b[3]);
            *(u32x4*)((bf16_t*)(ws + WS_WSB) + (size_t)row * 128 + seg * 8) = o;
        }
    }
    bf16_t* xb = (bf16_t*)(ws + WS_XB); float* ssq = (float*)(ws + WS_SSQ);
    for (int m = gw; m < AROWS; m += 2 * NGW) {
        const int m2 = m + NGW; const bool two = m2 < AROWS;
        const float* s1 = m < T ? p.in[0] + (size_t)m * DM : p.in[1] + (size_t)(m - T) * DM;
        const float* s2 = !two ? s1 : (m2 < T ? p.in[0] + (size_t)m2 * DM : p.in[1] + (size_t)(m2 - T) * DM);
        const f32x4* x1 = (const f32x4*)s1 + lane; const f32x4* x2 = (const f32x4*)s2 + lane;
        f32x4 a[4], b[4];
#pragma unroll
        for (int j = 0; j < 4; ++j) { a[j] = x1[64 * j]; b[j] = x2[64 * j]; }
        float sa = 0.f, sb = 0.f;
#pragma unroll
        for (int j = 0; j < 4; ++j) { sa += (a[j].x * a[j].x + a[j].y * a[j].y) + (a[j].z * a[j].z + a[j].w * a[j].w); sb += (b[j].x * b[j].x + b[j].y * b[j].y) + (b[j].z * b[j].z + b[j].w * b[j].w); }
        sa = wave_sum(sa); sb = wave_sum(sb);
        u32x2* o1 = (u32x2*)(xb + (size_t)m * DM) + lane;
#pragma unroll
        for (int j = 0; j < 4; ++j) { u32x2 w; w.x = pk_bf16(a[j].x, a[j].y); w.y = pk_bf16(a[j].z, a[j].w); o1[64 * j] = w; }
        if (lane < 4) ssq[(size_t)m * 4 + lane] = lane == 0 ? sa : 0.f;
        if (two) {
            u32x2* o2 = (u32x2*)(xb + (size_t)m2 * DM) + lane;
#pragma unroll
            for (int j = 0; j < 4; ++j) { u32x2 w; w.x = pk_bf16(b[j].x, b[j].y); w.y = pk_bf16(b[j].z, b[j].w); o2[64 * j] = w; }
            if (lane < 4) ssq[(size_t)m2 * 4 + lane] = lane == 0 ? sb : 0.f;
        }
    }
}

#define MFMA32(a, b, c) __builtin_amdgcn_mfma_f32_32x32x16_bf16((a), (b), (c), 0, 0, 0)
__device__ __forceinline__ bf16x8 vtr8(LAS const char* p, int hi_off) {
    const s16x4 lo = __builtin_amdgcn_ds_read_tr16_b64_v4i16((LAS s16x4*)p);
    const s16x4 hi = __builtin_amdgcn_ds_read_tr16_b64_v4i16((LAS s16x4*)(p + hi_off));
    return __builtin_shufflevector(lo, hi, 0, 1, 2, 3, 4, 5, 6, 7);
}
__device__ __forceinline__ bf16x8 pack8(const f32x16& x, int s) {
    u32x4 p; p.x = pk_bf16(x[8 * s], x[8 * s + 1]); p.y = pk_bf16(x[8 * s + 2], x[8 * s + 3]); p.z = pk_bf16(x[8 * s + 4], x[8 * s + 5]); p.w = pk_bf16(x[8 * s + 6], x[8 * s + 7]);
    return __builtin_bit_cast(bf16x8, p);
}
constexpr int ATT_KP = 272, ATT_VP = 320, ATT_KBUF = 64 * ATT_KP, ATT_VBUF = 64 * ATT_VP, ATT_VOFF = 2 * ATT_KBUF;

__device__ __forceinline__ float xor32_max(float m) {
    auto rr = __builtin_amdgcn_permlane32_swap(__float_as_uint(m), __float_as_uint(m), false, false);
    return fmaxf(__uint_as_float(rr[0]), __uint_as_float(rr[1]));
}
__device__ __forceinline__ float xor32_sum(float m) {
    auto rr = __builtin_amdgcn_permlane32_swap(__float_as_uint(m), __float_as_uint(m), false, false);
    return __uint_as_float(rr[0]) + __uint_as_float(rr[1]);
}
template <bool DIFF, int NDV>
__device__ __forceinline__ void attn_tile(f32x16 (&o)[NDV], float& l, const bf16x8 (&qf)[4], const float sref, LAS const char* kc, LAS const char* vc,
                                          bool masked, int kb0, int qrow) {
    bf16x8 kf[8];
#pragma unroll
    for (int ks = 0; ks < 4; ++ks) { kf[2 * ks] = *(LAS const bf16x8*)(kc + ks * 32); kf[2 * ks + 1] = *(LAS const bf16x8*)(kc + 32 * ATT_KP + ks * 32); }
    f32x16 s0, s1;
#pragma unroll
    for (int i = 0; i < 16; ++i) { s0[i] = 0.f; s1[i] = 0.f; }
#pragma unroll
    for (int ks = 0; ks < 4; ++ks) { s0 = MFMA32(kf[2 * ks], qf[ks], s0); s1 = MFMA32(kf[2 * ks + 1], qf[ks], s1); }
    __builtin_amdgcn_sched_barrier(0);
    bf16x8 vf[8];
#pragma unroll
    for (int d = 0; d < 2; ++d)
#pragma unroll
        for (int kk = 0; kk < 4; ++kk) vf[d * 4 + kk] = vtr8(vc + kk * 16 * ATT_VP + d * 64, 8 * ATT_VP);
    __builtin_amdgcn_sched_barrier(0);
    if (DIFF && masked) {
#pragma unroll
        for (int i = 0; i < 16; ++i) { const int key = kb0 + (i & 3) + 8 * (i >> 2); if (key > qrow) s0[i] = -1e30f; if (key + 32 > qrow) s1[i] = -1e30f; }
    }
    if (sref != 0.f) {
#pragma unroll
        for (int i = 0; i < 16; ++i) { s0[i] -= sref; s1[i] -= sref; }
    }
    float rs = 0.f;
#pragma unroll
    for (int i = 0; i < 16; ++i) { s0[i] = fast_exp2(s0[i]); s1[i] = fast_exp2(s1[i]); rs += s0[i] + s1[i]; }
    l += rs;
    bf16x8 pb[4];
    pb[0] = pack8(s0, 0); pb[1] = pack8(s0, 1); pb[2] = pack8(s1, 0); pb[3] = pack8(s1, 1);
    if (NDV == 4) {
        bf16x8 vf2[8];
#pragma unroll
        for (int d = 0; d < 2; ++d)
#pragma unroll
            for (int kk = 0; kk < 4; ++kk) vf2[d * 4 + kk] = vtr8(vc + kk * 16 * ATT_VP + (d + 2) * 64, 8 * ATT_VP);
        __builtin_amdgcn_sched_barrier(0);
#pragma unroll
        for (int kk = 0; kk < 4; ++kk) { o[0] = MFMA32(vf[kk], pb[kk], o[0]); o[1] = MFMA32(vf[4 + kk], pb[kk], o[1]); }
#pragma unroll
        for (int kk = 0; kk < 4; ++kk) { o[2] = MFMA32(vf2[kk], pb[kk], o[2]); o[NDV - 1] = MFMA32(vf2[4 + kk], pb[kk], o[NDV - 1]); }
    } else {
#pragma unroll
        for (int kk = 0; kk < 4; ++kk) { o[0] = MFMA32(vf[kk], pb[kk], o[0]); o[1] = MFMA32(vf[4 + kk], pb[kk], o[1]); }
    }
}

template <bool DIFF>
__device__ __forceinline__ void attn_unit(LAS unsigned char* lds, const bf16_t* Qp, int ldq, const bf16_t* Kp, const bf16_t* Vp, int ldkv,
                                          bf16_t* Op, int qb, float lam, const float* subln, const float sbound, const int tid) {
    constexpr int NDV = DIFF ? 4 : 2;
    const int w = __builtin_amdgcn_readfirstlane(tid >> 6), lane = tid & 63, r = lane & 31, h = lane >> 5, c = w >> 2, sq = w & 3;
    const int nkt = DIFF ? 2 * qb + 2 : 4;
    const int my_last = DIFF ? ((qb * 128 + sq * 32 + 31) >> 6) : 3;
    const int qrow = qb * 128 + sq * 32 + r;
    bf16x8 qf[4];
    { const bf16_t* qptr = Qp + (size_t)(sq * 32 + r) * ldq + c * 64 + 8 * h;
#pragma unroll
      for (int ks = 0; ks < 4; ++ks) qf[ks] = *(const bf16x8*)(qptr + 16 * ks); }
    const int srow = tid >> 3, sseg = tid & 7;
    const bf16_t* kg = Kp + (size_t)srow * ldkv + sseg * 16;
    const bf16_t* vg = Vp + (size_t)srow * ldkv + sseg * 16;
    const size_t g64 = (size_t)64 * ldkv;
    LAS unsigned char* kw = lds + srow * ATT_KP + sseg * 32;
    LAS unsigned char* vw = lds + ATT_VOFF + srow * ATT_VP + sseg * 32;
    u32x4 ra[4], rb[4];
#define ATT_LOAD(R, kti) do { const bf16_t* _k = kg + (size_t)(kti) * g64; const bf16_t* _v = vg + (size_t)(kti) * g64; \
        R[0] = *(const u32x4*)_k; R[1] = *(const u32x4*)(_k + 8); R[2] = *(const u32x4*)_v; R[3] = *(const u32x4*)(_v + 8); } while (0)
#define ATT_WRITE(R, buf) do { LAS unsigned char* _k = kw + (buf) * ATT_KBUF; LAS unsigned char* _v = vw + (buf) * ATT_VBUF; \
        *(LAS u32x4*)_k = R[0]; *(LAS u32x4*)(_k + 16) = R[1]; *(LAS u32x4*)_v = R[2]; *(LAS u32x4*)(_v + 16) = R[3]; } while (0)
    ATT_LOAD(ra, 0);
    ATT_LOAD(rb, 1);
    ATT_WRITE(ra, 0);
    f32x16 o[NDV];
#pragma unroll
    for (int d = 0; d < NDV; ++d)
#pragma unroll
        for (int i = 0; i < 16; ++i) o[d][i] = 0.f;
    float l = 0.f;
    const float sref = fmaxf(sbound - 64.f, 0.f);
    asm volatile("" :: "v"(qf[0]), "v"(qf[1]), "v"(qf[2]), "v"(qf[3]));
    __syncthreads();
    LAS const char* kb = (LAS const char*)lds + r * ATT_KP + (c * 64 + 8 * h) * 2;
    const int q4 = (lane & 15) >> 2, p4 = lane & 3, blk = (lane >> 4) & 1;
    LAS const char* vb = (LAS const char*)lds + ATT_VOFF + (4 * h + q4) * ATT_VP + ((DIFF ? 0 : c * 64) + 16 * blk) * 2 + 8 * p4;
    const int q0w = qb * 128 + sq * 32;
    typedef __attribute__((address_space(1))) const char* gcptr; typedef __attribute__((address_space(1))) const u32x4* gvptr;
    unsigned long long pa = (unsigned long long)(kg + (size_t)min(2, nkt - 1) * g64);
    asm volatile("" : "+v"(pa));
    const long kvd = (long)((const char*)Vp - (const char*)Kp);
#define ATT_STEP(kti, LD, WR) do { \
        LD[0] = *(gvptr)(gcptr)pa; LD[1] = *(gvptr)((gcptr)pa + 16); LD[2] = *(gvptr)((gcptr)pa + kvd); LD[3] = *(gvptr)((gcptr)pa + kvd + 16);     \
        pa = (unsigned long long)(kg + (size_t)min((kti) + 3, nkt - 1) * g64); asm volatile("" : "+v"(pa)); \
        if ((kti) <= my_last) attn_tile<DIFF, NDV>(o, l, qf, sref, kb + ((kti) & 1) * ATT_KBUF, vb + ((kti) & 1) * ATT_VBUF, (kti) * 64 + 63 > q0w, (kti) * 64 + 4 * h, qrow); \
        if ((kti) + 1 < nkt) ATT_WRITE(WR, ((kti) + 1) & 1); \
        __syncthreads(); } while (0)
#pragma unroll 1
    for (int kt = 0; kt < nkt; kt += 2) {
        ATT_STEP(kt, ra, rb);
        ATT_STEP(kt + 1, rb, ra);
    }
#undef ATT_STEP
#undef ATT_LOAD
#undef ATT_WRITE
    l = xor32_sum(l);
    const float inv = 1.f / l;
    if (!DIFF) {
        bf16_t* orow = Op + (size_t)(sq * 32 + r) * DM + c * 64 + 4 * h;
#pragma unroll
        for (int d = 0; d < NDV; ++d)
#pragma unroll
            for (int g = 0; g < 4; ++g) {
                u32x2 wv; wv.x = pk_bf16(o[d][4 * g] * inv, o[d][4 * g + 1] * inv); wv.y = pk_bf16(o[d][4 * g + 2] * inv, o[d][4 * g + 3] * inv);
                *(u32x2*)(orow + d * 32 + 8 * g) = wv;
            }
    } else {
        LAS float* ex = (LAS float*)lds + sq * 4096 + lane;
        f32x4 gn[16];
        if (c == 0) {
#pragma unroll
            for (int d = 0; d < NDV; ++d)
#pragma unroll
                for (int g = 0; g < 4; ++g) gn[d * 4 + g] = *(const f32x4*)(subln + d * 32 + 8 * g + 4 * h);
        }
        if (c == 1) {
            const float sc = lam * inv;
#pragma unroll
            for (int d = 0; d < NDV; ++d)
#pragma unroll
                for (int i = 0; i < 16; ++i) ex[(d * 16 + i) * 64] = o[d][i] * sc;
        }
        __syncthreads();
        if (c == 0) {
            float ss = 0.f;
#pragma unroll
            for (int d = 0; d < NDV; ++d)
#pragma unroll
                for (int i = 0; i < 16; ++i) { const float v = o[d][i] * inv - ex[(d * 16 + i) * 64]; o[d][i] = v; ss += v * v; }
            ss = xor32_sum(ss);
            const float rr = rsqrtf(ss * (1.f / 128.f) + EPS) * (1.f - LAMBDA_INIT);
            bf16_t* orow = Op + (size_t)(sq * 32 + r) * DM + 4 * h;
#pragma unroll
            for (int d = 0; d < NDV; ++d)
#pragma unroll
                for (int g = 0; g < 4; ++g) {
                    const f32x4 gv = gn[d * 4 + g];
                    u32x2 wv; wv.x = pk_bf16(o[d][4 * g] * rr * gv[0], o[d][4 * g + 1] * rr * gv[1]); wv.y = pk_bf16(o[d][4 * g + 2] * rr * gv[2], o[d][4 * g + 3] * rr * gv[3]);
                    *(u32x2*)(orow + d * 32 + 8 * g) = wv;
                }
        }
        __syncthreads();
    }
}

struct GmlpRegs { u32x4 v[4]; u32x2 uv[8]; u32x4 w[8]; float bias; };
__device__ __forceinline__ void gmlp_load(GmlpRegs& R, const bf16_t* zb, const bf16_t* wsb, const float* bsall, int u, int tid, int t, int h, int cb0) {
    const int b = u / 96, rem = u % 96, n = rem / 6, g = rem % 6;
    const bf16_t* zrows = zb + ((size_t)b * SEQ + n * 128) * NMIX0;
    const bf16_t* urow = zrows + (size_t)t * NMIX0 + g * 128 + 4 * h;
#pragma unroll
    for (int i = 0; i < 8; ++i) R.uv[i] = *(const u32x2*)(urow + (cb0 + (i >> 2)) * 32 + 8 * (i & 3));
    const bf16_t* wrow = wsb + (size_t)g * 128 * 128 + (size_t)t * 128 + 8 * h;
#pragma unroll
    for (int i = 0; i < 8; ++i) R.w[i] = *(const u32x4*)(wrow + 16 * i);
    R.bias = bsall[g * 128 + t];
    const bf16_t* vgp = zrows + (size_t)(tid >> 2) * NMIX0 + 768 + g * 128 + (tid & 3) * 32;
#pragma unroll
    for (int j = 0; j < 4; ++j) R.v[j] = *(const u32x4*)(vgp + 8 * j);
}
__device__ __forceinline__ void gmlp_compute(LAS unsigned char* lds, const GmlpRegs& R, bf16_t* cat, int u, int tid, int lane, int t, int h, int cb0) {
    constexpr int VP = 320, GOFF = 49152;
    const int b = u / 96, rem = u % 96, n = rem / 6, g = rem % 6;
    {
        const int row = tid >> 2, qtr = tid & 3;
        float ss = 0.f;
#pragma unroll
        for (int j = 0; j < 4; ++j)
#pragma unroll
            for (int e = 0; e < 4; ++e) { const float x = bf_lo(R.v[j][e]), y = bf_hi(R.v[j][e]); ss += x * x + y * y; }
        ss += __shfl_xor(ss, 1); ss += __shfl_xor(ss, 2);
        const float rs = rsqrtf(ss * (1.f / 128.f) + EPS);
        LAS const unsigned char* gp = lds + GOFF + (g * 128 + qtr * 32) * 4;
        LAS unsigned char* dst = lds + row * VP + qtr * 64;
#pragma unroll
        for (int j = 0; j < 4; ++j) {
            const f32x4 g0 = *(LAS const f32x4*)(gp + 32 * j), g1 = *(LAS const f32x4*)(gp + 32 * j + 16);
            u32x4 o;
            o.x = pk_bf16(bf_lo(R.v[j].x) * rs * g0[0], bf_hi(R.v[j].x) * rs * g0[1]); o.y = pk_bf16(bf_lo(R.v[j].y) * rs * g0[2], bf_hi(R.v[j].y) * rs * g0[3]);
            o.z = pk_bf16(bf_lo(R.v[j].z) * rs * g1[0], bf_hi(R.v[j].z) * rs * g1[1]); o.w = pk_bf16(bf_lo(R.v[j].w) * rs * g1[2], bf_hi(R.v[j].w) * rs * g1[3]);
            *(LAS u32x4*)(dst + 16 * j) = o;
        }
    }
    __syncthreads();
    const int q4 = (lane & 15) >> 2, p4 = lane & 3, blk = (lane >> 4) & 1;
    LAS const char* vb = (LAS const char*)lds + (8 * h + q4) * VP + (cb0 * 32 + 16 * blk) * 2 + 8 * p4;
    f32x16 a0, a1;
#pragma unroll
    for (int i = 0; i < 16; ++i) { a0[i] = 0.f; a1[i] = 0.f; }
#pragma unroll
    for (int ks = 0; ks < 8; ++ks) {
        const bf16x8 wf = __builtin_bit_cast(bf16x8, R.w[ks]);
        const bf16x8 v0 = vtr8(vb + ks * 16 * VP, 4 * VP), v1 = vtr8(vb + ks * 16 * VP + 64, 4 * VP);
        a0 = MFMA32(v0, wf, a0); a1 = MFMA32(v1, wf, a1);
    }
    bf16_t* orow = cat + ((size_t)b * SEQ + n * 128 + t) * DM + g * 128 + 4 * h;
    const float bias = R.bias;
#pragma unroll
    for (int cbi = 0; cbi < 2; ++cbi)
#pragma unroll
        for (int gq = 0; gq < 4; ++gq) {
            const int c0 = (cb0 + cbi) * 32 + 8 * gq;
            const u32x2 uu = R.uv[cbi * 4 + gq];
            const f32x16& a = cbi ? a1 : a0;
            u32x2 wv; wv.x = pk_bf16(bf_lo(uu.x) * (a[4 * gq] + bias), bf_hi(uu.x) * (a[4 * gq + 1] + bias));
            wv.y = pk_bf16(bf_lo(uu.y) * (a[4 * gq + 2] + bias), bf_hi(uu.y) * (a[4 * gq + 3] + bias));
            *(u32x2*)(orow + c0) = wv;
        }
    __syncthreads();
}
__device__ __forceinline__ void gmlp_phase(LAS unsigned char* lds, const bf16_t* zb, const bf16_t* wsb, const float* bsall, const float* vgall, bf16_t* cat, int vcu, int G, const int tid) {
    constexpr int GOFF = 49152;
    if (vcu >= 1536) return;
    if (tid < 192) *(LAS f32x4*)(lds + GOFF + tid * 16) = *(const f32x4*)(vgall + tid * 4);
    const int w = __builtin_amdgcn_readfirstlane(tid >> 6), lane = tid & 63, r = lane & 31, h = lane >> 5;
    const int tb = w & 3, cb0 = (w >> 2) * 2; int t = 32 * tb + r; asm volatile("" : "+v"(t));
    int u = vcu;
    GmlpRegs A; gmlp_load(A, zb, wsb, bsall, u, tid, t, h, cb0);
    __syncthreads();
#pragma unroll 1
    for (;;) {
        const int un = u + G; const bool hn = un < 1536;
        GmlpRegs B; gmlp_load(B, zb, wsb, bsall, hn ? un : u, tid, t, h, cb0);
        gmlp_compute(lds, A, cat, u, tid, lane, t, h, cb0);
        if (!hn) break;
        A = B; u = un;
    }
}

#define XB_TMO      128
#define XB_XCNT(j)  (256  + 64 * (j))
#define XB_XSUB(j)  (1280 + 64 * (j))
#define XB_XGEN(j)  (2304 + 64 * (j))
#define XB_TOP      3328
#define XB_TOPGEN   3392
#define XCD_BAR_WORDS 3456
#define XB_SPIN_CAP (1u << 20)
__device__ __forceinline__ unsigned xb_ld(unsigned* p)              { return __hip_atomic_load(p, __ATOMIC_RELAXED, __HIP_MEMORY_SCOPE_AGENT); }
__device__ __forceinline__ unsigned xb_add(unsigned* p, unsigned v) { return __hip_atomic_fetch_add(p, v, __ATOMIC_RELAXED, __HIP_MEMORY_SCOPE_AGENT); }
__device__ __forceinline__ unsigned xb_xcc_id() { return (unsigned)__builtin_amdgcn_s_getreg((3 << 11) | 20) & 0xFu; }
#define XB_SPIN(cond, bar) do { unsigned _sp = 0; while (cond) { __builtin_amdgcn_s_sleep(1); \
    if ((++_sp & 255u) == 0u) { if (xb_ld(&(bar)[XB_TMO])) break; if (_sp > XB_SPIN_CAP) { atomicAdd(&(bar)[XB_TMO], 1u); break; } } } } while (0)
struct XcdBarrier { unsigned* bar; unsigned x; volatile LAS unsigned* st; };
__device__ __forceinline__ XcdBarrier xcd_barrier_post(unsigned* bar, volatile LAS unsigned* st, const int tid) {
    XcdBarrier b; b.bar = bar; b.x = xb_xcc_id(); b.st = st;
    if (tid == 0) (void)xb_add(&bar[XB_XCNT(b.x)], 1u);
    return b;
}
__device__ __forceinline__ void xcd_barrier_complete(unsigned* bar, unsigned x, unsigned& nloc, unsigned& nx) {
    const unsigned G = gridDim.x * gridDim.y * gridDim.z;
    unsigned sum, cnt, mine, sp = 0u;
    for (;;) {
        sum = 0u; cnt = 0u; mine = 0u;
#pragma unroll
        for (unsigned j = 0; j < 16; ++j) { const unsigned c = xb_ld(&bar[XB_XCNT(j)]); sum += c; cnt += (c > 0u) ? 1u : 0u; mine = (j == x) ? c : mine; }
        if (sum == G) break;
        __builtin_amdgcn_s_sleep(1);
        if ((++sp & 255u) == 0u) { if (xb_ld(&bar[XB_TMO])) break; if (sp > XB_SPIN_CAP) { atomicAdd(&bar[XB_TMO], 1u); break; } }
    }
    nloc = mine > 0u ? mine : 1u; nx = cnt > 0u ? cnt : 1u;
}
__device__ __forceinline__ void xcd_barrier(const XcdBarrier& b, const int tid) {
    asm volatile("s_waitcnt vmcnt(0)" ::: "memory");
    __syncthreads();
    if (tid == 0) {
        unsigned* bar = b.bar;
        __builtin_amdgcn_s_waitcnt(0);
        unsigned nloc = b.st[0], nx = b.st[1];
        if (nloc == 0u) { xcd_barrier_complete(bar, b.x, nloc, nx); b.st[0] = nloc; b.st[1] = nx; }
        const unsigned old = xb_add(&bar[XB_XSUB(b.x)], 1u);
        const unsigned gen = old / nloc;
        if (old + 1u == (gen + 1u) * nloc) {
            __builtin_amdgcn_fence(__ATOMIC_RELEASE, "agent");
            asm volatile("s_waitcnt vmcnt(0)" ::: "memory");
            const unsigned og = xb_add(&bar[XB_TOP], 1u);
            const unsigned tg = og / nx;
            if (og + 1u == (tg + 1u) * nx) xb_add(&bar[XB_TOPGEN], 1u);
            else XB_SPIN(xb_ld(&bar[XB_TOPGEN]) == tg, bar);
            __builtin_amdgcn_fence(__ATOMIC_ACQUIRE, "agent");
            xb_add(&bar[XB_XGEN(b.x)], 1u);
            asm volatile("s_waitcnt vmcnt(0)" ::: "memory");
        } else {
            XB_SPIN(xb_ld(&bar[XB_XGEN(b.x)]) == gen, bar);
            __builtin_amdgcn_fence(__ATOMIC_ACQUIRE, "agent");
            asm volatile("s_waitcnt vmcnt(0)" ::: "memory");
        }
    }
    __syncthreads();
}

#define PHASE_SEQ 0, 1, 2, 3, 5, 6, 7, 8, 9, 10, 11, 13, 14, 15, 16
__constant__ unsigned char phase_seq[] = {PHASE_SEQ};
constexpr int N_PHASES = sizeof(phase_seq);
__global__ void __launch_bounds__(512, 2) fwd_megakernel(Params p_, int ph_lo, int ph_hi) {
    extern __shared__ __attribute__((aligned(16))) unsigned char lds_raw[];
    LAS unsigned char* lds = (LAS unsigned char*)lds_raw;
    cg::grid_group grid = cg::this_grid();
    volatile LAS unsigned* bst = (volatile LAS unsigned*)(lds + 131072 + 512);
    if (threadIdx.x < 2) bst[threadIdx.x] = 0u;
    unsigned* barw = (unsigned*)(p_.ws + WS_BAR);
    if (blockIdx.x == 0) for (int i = threadIdx.x; i < XCD_BAR_WORDS; i += 512) barw[i] = 0u;
    XcdBarrier xbar; xbar.bar = barw; xbar.x = 0; xbar.st = bst;
#pragma unroll 1
    for (int phi = ph_lo; phi < ph_hi; ++phi) {
        const int ph = phase_seq[phi];
        int tid = threadIdx.x; asm volatile("" : "+v"(tid));
        unsigned long long kab = (unsigned long long)__builtin_amdgcn_kernarg_segment_ptr(); asm volatile("" : "+s"(kab));
        const Params& p = *(const Params*)(const __attribute__((address_space(4))) char*)kab;
        const int lane = tid & 63, wave = __builtin_amdgcn_readfirstlane(tid >> 6);
        int G = gridDim.x, bx = blockIdx.x; asm volatile("" : "+s"(G), "+s"(bx));
        unsigned char* ws = p.ws;
        bf16_t* xb = (bf16_t*)(ws + WS_XB); bf16_t* act = (bf16_t*)(ws + WS_ACT); bf16_t* zb = act; bf16_t* cat = (bf16_t*)(ws + WS_CAT);
        bf16_t* memkv = (bf16_t*)(ws + WS_MEMKV); float* ssq = (float*)(ws + WS_SSQ);
        float* X = p.out;
        if (ph == 0) {
            prologue(p, lds, bx * 8 + wave, G * 8, wave, lane);
        } else if (ph < 17) {
            const int q = ph - 1, layer = q >> 3, s = q & 7;
            const int ldz = layer == 0 ? NMIX0 : NMIX1, qmoff = layer == 0 ? 1536 : 2304;
            if (s == 0 || s == 6) {
                const int mat = layer * 2 + (s == 6);
                pg8::Gemm g{xb, (const bf16_t*)(ws + WS_WFFIN + mat * SZ_WFFIN), T, 2 * FF, DM};
                pg8::Order S; S.init(T, 2 * FF, G, bx);
                pg8::EpiSwiglu E{act, ssq};
                pg8::gemm_phase<pg8::EpiSwiglu>(lds, g, S, E, tid);
            } else if (s == 1 || s == 7 || s == 5) {
                const int mat = layer * 2 + (s == 7);
                const bool op = s == 5;
                pg8::Gemm g{op ? cat : act, (const bf16_t*)(ws + (op ? WS_WO + (size_t)layer * DM * DM * 2 : WS_WFFOUT + mat * SZ_WFFOUT)), T, DM, op ? DM : FF};
                pg8::Order S; S.init(T, DM, G, bx);
                pg8::EpiResid E{xb, ph == 16 ? X : nullptr, ssq, op ? 1.f : 0.5f, (LAS float*)(lds + 131072 + 4096), tid};
                pg8::gemm_phase<pg8::EpiResid>(lds, g, S, E, tid);
            } else if (s == 2) {
                pg8::Gemm g{xb, (const bf16_t*)(ws + (layer == 0 ? WS_WMIX0 : WS_WMIX1)), T, ldz, DM};
                pg8::Order S; if (layer == 0) S.init(T, NMIX0, G, bx, 16, 4); else S.init(T, NMIX1, G, bx);
                pg8::EpiZ E{zb, ldz, layer, layer == 0 ? 7 : 10, ssq, memkv, p.in[16], p.in[17], p.in[8], p.in[9]};
                pg8::gemm_phase<pg8::EpiZ>(lds, g, S, E, tid);
            } else if (s == 3) {
            } else {
                float sb_mem, sb_diff = 0.f;
                { float a = fabsf(p.in[8][layer * 64 + lane]), b = fabsf(p.in[9][layer * 64 + lane]);
#pragma unroll
                  for (int o_ = 1; o_ < 64; o_ <<= 1) { a = fmaxf(a, __shfl_xor(a, o_)); b = fmaxf(b, __shfl_xor(b, o_)); }
                  sb_mem = __uint_as_float(__builtin_amdgcn_readfirstlane(__float_as_uint(64.f * C2 * a * b * 1.02f + 0.1f))); }
                if (layer == 1) { float a = fabsf(p.in[16][lane]), b = fabsf(p.in[17][lane]);
#pragma unroll
                  for (int o_ = 1; o_ < 64; o_ <<= 1) { a = fmaxf(a, __shfl_xor(a, o_)); b = fmaxf(b, __shfl_xor(b, o_)); }
                  sb_diff = __uint_as_float(__builtin_amdgcn_readfirstlane(__float_as_uint(64.f * C2 * a * b * 1.02f + 0.1f))); }
                const int vcu = (G % 8 == 0) ? (bx % 8) * (G / 8) + bx / 8 : bx;
                if (layer == 0) {
                    gmlp_phase(lds, zb, (const bf16_t*)(ws + WS_WSB), p.in[14], p.in[12], cat, vcu, G, tid);
                } else {
                    const float* lp = p.in[18];
                    const float sa = wave_sum(lp[lane] * lp[64 + lane]), sb = wave_sum(lp[128 + lane] * lp[192 + lane]);
                    const float lam = __uint_as_float(__builtin_amdgcn_readfirstlane(__float_as_uint(__expf(sa) - __expf(sb) + LAMBDA_INIT)));
#pragma unroll 1
                    for (int u = vcu; u < 1536; u += G) {
                        const int pi = u % 768, k = u / 768;
                        const int bh = pi >> 3, qlo = pi & 7, b = bh / 6, hh = bh % 6;
                        const int qb = k == 0 ? 15 - qlo : qlo; const size_t rb = (size_t)b * SEQ;
                        attn_unit<true>(lds, zb + (rb + qb * 128) * NMIX1 + hh * 128, NMIX1, zb + rb * NMIX1 + 768 + hh * 128, zb + rb * NMIX1 + 1536 + hh * 128, NMIX1,
                                        cat + (rb + qb * 128) * DM + hh * 128, qb, lam, p.in[19], sb_diff, tid);
                    }
                }
#pragma unroll 1
                for (int u = vcu; u < 512; u += G) {
                    const int b = u >> 5, pr = (u >> 4) & 1, qb = u & 15; const size_t rb = (size_t)b * SEQ;
                    attn_unit<false>(lds, zb + (rb + qb * 128) * ldz + qmoff + pr * 128, ldz, memkv + (size_t)b * MEML * DM + layer * 512 + pr * 128,
                                     memkv + (size_t)b * MEML * DM + layer * 512 + 256 + pr * 128, DM, cat + (rb + qb * 128) * DM + 768 + pr * 128, qb, 0.f, nullptr, sb_mem, tid);
                }
            }
        }
        if (phi + 1 < ph_hi) { if (phi == ph_lo) { grid.sync(); xbar = xcd_barrier_post(barw, bst, tid); } else xcd_barrier(xbar, tid); }
    }
}

extern "C" void kernel_launch(void* const* d_in, const int* in_sizes, int n_in, void* d_out, int out_size, void* d_ws, size_t ws_size, hipStream_t stream) {
    static int grid = 0;
    if (grid == 0) {
        if (n_in != 20 || out_size != T * DM || ws_size < WS_END) { fprintf(stderr, "kernel_launch: unexpected shapes (n_in %d, out %d, ws %zu, need %zu)\n", n_in, out_size, ws_size, (size_t)WS_END); grid = -1; return; }
        int dev = 0, cus = 0, per_cu = 0;
        (void)hipGetDevice(&dev);
        (void)hipDeviceGetAttribute(&cus, hipDeviceAttributeMultiprocessorCount, dev);
        if (hipFuncSetAttribute((const void*)fwd_megakernel, hipFuncAttributeMaxDynamicSharedMemorySize, LDS_BYTES) != hipSuccess) { fprintf(stderr, "kernel_launch: hipFuncSetAttribute failed\n"); grid = -1; return; }
        if (hipOccupancyMaxActiveBlocksPerMultiprocessor(&per_cu, (const void*)fwd_megakernel, 512, LDS_BYTES) != hipSuccess || per_cu < 1) { fprintf(stderr, "kernel_launch: occupancy query says %d\n", per_cu); per_cu = 1; }
        (void)hipGetLastError();
        grid = cus * 1;
        (void)per_cu;
    }
    if (grid < 0) return;
    Params p{};
    for (int i = 0; i < 20; ++i) p.in[i] = (const float*)d_in[i];
    p.out = (float*)d_out; p.ws = (unsigned char*)d_ws;
    int ph_lo = 0, ph_hi = N_PHASES;
    void* args[] = {&p, &ph_lo, &ph_hi};
    hipError_t e = hipLaunchCooperativeKernel((const void*)fwd_megakernel, dim3(grid), dim3(512), args, LDS_BYTES, stream);
    if (e != hipSuccess) fprintf(stderr, "cooperative launch failed: %s (grid %d)\n", hipGetErrorString(e), grid);
}
```

```cpp
#include <hip/hip_runtime.h>
#include <hip/hip_cooperative_groups.h>
#include <cstdio>
#include <cstdint>
namespace cg = cooperative_groups;

#define LAS __attribute__((address_space(3)))
typedef unsigned short bf16_t;
typedef short bf16x8 __attribute__((ext_vector_type(8)));
typedef short s16x4 __attribute__((ext_vector_type(4)));
typedef float f32x2 __attribute__((ext_vector_type(2)));
typedef float f32x4 __attribute__((ext_vector_type(4)));
typedef float f32x16 __attribute__((ext_vector_type(16)));
typedef unsigned u32x2 __attribute__((ext_vector_type(2)));
typedef unsigned u32x4 __attribute__((ext_vector_type(4)));
typedef __bf16 bf16x2_t __attribute__((ext_vector_type(2)));
typedef double d64x2 __attribute__((ext_vector_type(2)));

constexpr int T = 32768, DM = 1024, FF = 2816, SEQ = 2048, NB = 16, MEML = 256, MROWS = NB * MEML, AROWS = T + MROWS;
constexpr int NMIX0 = 1792, NMIX1 = 2560;
constexpr float EPS = 1e-6f;
constexpr float C2 = 0.125f * 1.4426950408889634f;
constexpr float LAMBDA_INIT = 0.35550906759f;

constexpr size_t MiB = 1u << 20;
constexpr size_t SZ_WFFIN = (size_t)2 * FF * DM * 2, SZ_WFFOUT = (size_t)DM * FF * 2;
constexpr size_t WS_WFFIN = 0;
constexpr size_t WS_WFFOUT = WS_WFFIN + 4 * SZ_WFFIN;
constexpr size_t WS_WMIX0 = WS_WFFOUT + 4 * SZ_WFFOUT;
constexpr size_t WS_WMIX1 = WS_WMIX0 + (size_t)2816 * DM * 2;
constexpr size_t WS_WO = WS_WMIX1 + (size_t)NMIX1 * DM * 2;
constexpr size_t WS_XB = WS_WO + (size_t)2 * DM * DM * 2;
constexpr size_t WS_ACT = WS_XB + (size_t)AROWS * DM * 2;
constexpr size_t WS_CAT = WS_ACT + (size_t)T * FF * 2;
constexpr size_t WS_MEMKV = WS_CAT + (size_t)T * DM * 2;
constexpr size_t WS_SSQ = WS_MEMKV + (size_t)MROWS * DM * 2;
constexpr size_t WS_BAR = WS_SSQ + (size_t)AROWS * 16 * 4;
constexpr size_t WS_WSB = WS_BAR + 16384;
constexpr size_t WS_END = WS_WSB + (size_t)6 * 128 * 128 * 2;

constexpr int LDS_BYTES = 147456;

__device__ __forceinline__ unsigned pk_bf16(float lo, float hi) { f32x2 v = {lo, hi}; bf16x2_t b = __builtin_convertvector(v, bf16x2_t); return __builtin_bit_cast(unsigned, b); }
__device__ __forceinline__ float bf_lo(unsigned u) { return __builtin_bit_cast(float, u << 16); }
__device__ __forceinline__ float bf_hi(unsigned u) { return __builtin_bit_cast(float, u & 0xffff0000u); }
__device__ __forceinline__ float wave_sum(float v) {
#pragma unroll
    for (int o = 1; o < 64; o <<= 1) v += __shfl_xor(v, o);
    return v;
}
__device__ __forceinline__ float fast_exp2(float x) { return __builtin_amdgcn_exp2f(x); }
__device__ __forceinline__ float fast_rcp(float x) { return __builtin_amdgcn_rcpf(x); }
__device__ __forceinline__ f32x2 gelu_pk(f32x2 v) {
    const f32x2 av = __builtin_elementwise_abs(v), d = av * 0.2316418882f + 1.0f;
    f32x2 t; t.x = __builtin_amdgcn_rcpf(d.x); t.y = __builtin_amdgcn_rcpf(d.y);
    f32x2 q = t * 0.5307027145f + (-0.7265760135f); q = q * t + 0.7107068705f; q = q * t + (-0.142248368f); q = q * t + 0.127414796f; q = q * t;
    const f32x2 s = (v * v) * (-0.72134752044f);
    f32x2 e; e.x = __builtin_amdgcn_exp2f(s.x); e.y = __builtin_amdgcn_exp2f(s.y);
    const f32x2 m = v * (q * e), r = v - m;
    f32x2 o; o.x = v.x < 0.f ? m.x : r.x; o.y = v.y < 0.f ? m.y : r.y; return o;
}
__device__ __forceinline__ f32x4 gelu4(f32x4 v) { f32x2 a = gelu_pk((f32x2){v[0], v[1]}), b = gelu_pk((f32x2){v[2], v[3]}); return (f32x4){a.x, a.y, b.x, b.y}; }
__device__ __forceinline__ float silu(float g) { return g * fast_rcp(1.f + fast_exp2(-1.4426950408889634f * g)); }
__device__ __forceinline__ float row_rstd(const float* ssq, int row) {
    const f32x4 s = *(const f32x4*)(ssq + (size_t)row * 4);
    return rsqrtf(((s.x + s.y) + (s.z + s.w)) * (1.f / DM) + EPS);
}

__device__ __forceinline__ void rstd_finish(const f32x4& raw0, const f32x4& raw1, float& rn0, float& rn1) {
    rn0 = rsqrtf(((raw0.x + raw0.y) + (raw0.z + raw0.w)) * (1.f / DM) + EPS); rn1 = rsqrtf(((raw1.x + raw1.y) + (raw1.z + raw1.w)) * (1.f / DM) + EPS);
    asm volatile("" :: "v"(rn0), "v"(rn1) : "memory");
}

namespace pg8 {
constexpr int BM = 256, BK = 64, HALF = 128, HTB = HALF * BK * 2, STAGE_BYTES = 8 * HTB, NXCD = 8, WGM = 8;
__host__ __device__ __forceinline__ int lds_byte(int r, int c) { const int st = (r >> 4) * 2 + (c >> 5), rr = r & 15, cc = c & 31, ob = rr * 64 + cc * 2; return st * 1024 + (ob ^ (((ob >> 9) & 1) << 5)); }
__host__ __device__ __forceinline__ void stage_rc(int b, int& R, int& C) { const int st = b / 1024, sb = b % 1024, swz = sb ^ (((sb >> 9) & 1) << 5); R = (st >> 1) * 16 + swz / 64; C = (st & 1) * 32 + (swz % 64) / 2; }
__host__ __device__ __forceinline__ int perm32(int rho) { const int n = rho >> 4, i = rho & 15; return 8 * (i >> 2) + 4 * n + (i & 3); }

struct Unit { int pm, pn; };
struct Gemm { const bf16_t* A; const bf16_t* Bt; int M, N, K; };

struct Order {
    int nM, nN, nwg, G, c, exM, total;
    __device__ void init(int M, int N, int G_, int c_, int exM_ = 0, int exN_ = 0) { nM = M / BM; nN = N / BM; nwg = nM * nN; G = G_; c = c_; exM = exM_; total = nwg + exM_ * exN_; }
    __device__ bool next(int i, Unit& u) const {
        const long L = (long)i * G + c; if (L >= total) return false;
        if (L >= nwg) { const int e = (int)L - nwg; u.pm = nM + e % exM; u.pn = nN + e / exM; return true; }
        int wgid = (int)L; { const int q = nwg / NXCD, r = nwg % NXCD, xcd = wgid % NXCD, off = wgid / NXCD; wgid = (xcd < r ? xcd * (q + 1) : r * (q + 1) + (xcd - r) * q) + off; }
        const int nig = WGM * nN, gid = wgid / nig, fm = gid * WGM, gsz = (nM - fm) < WGM ? (nM - fm) : WGM;
        u.pm = fm + ((wgid % nig) % gsz); u.pn = (wgid % nig) / gsz; return true;
    }
};


struct EpiSwiglu {
    static constexpr bool NEEDS_RSTD = true, EARLY_RSTD = true;
    bf16_t* O; const float* ssq;
    __device__ __forceinline__ void operator()(const f32x4 (&acc)[2][2][4][2], const Unit& u, int wr, int wc, int fr, int fq, float rp0, float rp1, const f32x4& raw0, const f32x4& raw1, float& rn0, float& rn1) const {
        const int row0 = u.pm * BM + wr * 64 + fr, col0 = u.pn * 128 + wc * 32 + 8 * fq;
        float rs[8];
#pragma unroll
        for (int k = 0; k < 8; ++k) rs[k] = __shfl((k >> 2) ? rp1 : rp0, fr + 16 * (k & 3));
#pragma unroll
        for (int ai = 0; ai < 2; ++ai)
#pragma unroll
            for (int m = 0; m < 4; ++m) {
                const int row = row0 + ai * HALF + m * 16; const float r = rs[ai * 4 + m];
                const float c1 = -1.4426950408889634f * r, r2 = r * r;
                const f32x4 ga = acc[ai][0][m][0], gb = acc[ai][0][m][1];
                const f32x4 ta = ga * c1, tb = gb * c1;
                f32x4 ea, eb;
#pragma unroll
                for (int j = 0; j < 4; ++j) { ea[j] = fast_exp2(ta[j]); eb[j] = fast_exp2(tb[j]); }
                const f32x4 da = ea + 1.f, db = eb + 1.f;
                f32x4 qa, qb;
#pragma unroll
                for (int j = 0; j < 4; ++j) { qa[j] = fast_rcp(da[j]); qb[j] = fast_rcp(db[j]); }
                const f32x4 oa = ((ga * acc[ai][1][m][0]) * r2) * qa, ob = ((gb * acc[ai][1][m][1]) * r2) * qb;
                u32x4 w;
                w.x = pk_bf16(oa[0], oa[1]); w.y = pk_bf16(oa[2], oa[3]); w.z = pk_bf16(ob[0], ob[1]); w.w = pk_bf16(ob[2], ob[3]);
                if (ai == 0 && m == 0) rstd_finish(raw0, raw1, rn0, rn1);
                *(u32x4*)(O + (size_t)row * FF + col0) = w;
            }
    }
};
struct EpiResid {
    static constexpr bool NEEDS_RSTD = false, EARLY_RSTD = false;
    bf16_t* xb; float* outf; float* ssq; float alpha; LAS float* red; int tid;
    __device__ __forceinline__ void operator()(const f32x4 (&acc)[2][2][4][2], const Unit& u, int wr, int wc, int fr, int fq, float, float, const f32x4&, const f32x4&, float&, float&) const {
        const int row0 = u.pm * BM + wr * 64 + fr, col0 = u.pn * BM + wc * 32 + 8 * fq;
        const size_t off0 = (size_t)row0 * DM + col0;
        u32x4 xv[3][2];
#define RESID_LOAD(slot, k) do { const bf16_t* _p = xb + off0 + (size_t)(((k) >> 2) * HALF + ((k) & 3) * 16) * DM; \
        xv[slot][0] = *(const u32x4*)(_p); xv[slot][1] = *(const u32x4*)(_p + HALF); } while (0)
        RESID_LOAD(0, 0); RESID_LOAD(1, 1);
#pragma unroll
        for (int k = 0; k < 8; ++k) {
            const int ai = k >> 2, m = k & 3;
            if (k + 2 < 8) RESID_LOAD((k + 2) % 3, k + 2);
            const size_t off = off0 + (size_t)(ai * HALF + m * 16) * DM; float sq = 0.f;
#pragma unroll
            for (int bj = 0; bj < 2; ++bj) {
                const u32x4 xr = xv[k % 3][bj];
                f32x4 x0 = {bf_lo(xr.x), bf_hi(xr.x), bf_lo(xr.y), bf_hi(xr.y)}, x1 = {bf_lo(xr.z), bf_hi(xr.z), bf_lo(xr.w), bf_hi(xr.w)};
                x0 = x0 + acc[ai][bj][m][0] * alpha; x1 = x1 + acc[ai][bj][m][1] * alpha;
                if (outf) { *(f32x4*)(outf + off + bj * HALF) = x0; *(f32x4*)(outf + off + bj * HALF + 4) = x1; }
                else {
                    u32x4 w; w.x = pk_bf16(x0[0], x0[1]); w.y = pk_bf16(x0[2], x0[3]); w.z = pk_bf16(x1[0], x1[1]); w.w = pk_bf16(x1[2], x1[3]);
                    *(u32x4*)(xb + off + bj * HALF) = w;
                    const f32x4 q = x0 * x0 + x1 * x1; sq += (q[0] + q[1]) + (q[2] + q[3]);
                }
            }
            if (!outf) {
                sq += __shfl_xor(sq, 16); sq += __shfl_xor(sq, 32);
                if (fq == 0) red[(ai * HALF + wr * 64 + m * 16 + fr) * 4 + wc] = sq;
            }
        }
#undef RESID_LOAD
        if (!outf) {
            __syncthreads();
            const int t = tid;
            if (t < BM) { const f32x4 s = *(const LAS f32x4*)(red + t * 4); ssq[(size_t)(u.pm * BM + t) * 4 + u.pn] = (s.x + s.y) + (s.z + s.w); }
        }
    }
};
struct EpiZ {
    static constexpr bool NEEDS_RSTD = true, EARLY_RSTD = false;
    bf16_t* Z; int ldz; int layer; int nmain; const float* ssq; bf16_t* KV; const float* gq; const float* gk; const float* gmq; const float* gmk;
    __device__ __forceinline__ void operator()(const f32x4 (&acc)[2][2][4][2], const Unit& u, int wr, int wc, int fr, int fq, float rp0, float rp1, const f32x4& raw0, const f32x4& raw1, float& rn0, float& rn1) const {
        const int arow0 = u.pm * BM + wr * 64 + fr, pn = u.pn;
        bf16_t* base; int ld;
        if (pn < nmain) { base = Z + (size_t)arow0 * ldz + pn * BM; ld = ldz; }
        else { base = KV + (size_t)(arow0 - T) * DM + (pn - nmain) * BM; ld = DM; }
        base += wc * 64 + 8 * fq;
        int mode = 0; const float* gain = gmq; float scale = 1.f;
        if (layer == 0) { if (pn < 6) mode = 1; else if (pn == 6) { mode = 2; scale = C2; } else if (pn == 7) { mode = 2; gain = gmk; } else if (pn == 9) { mode = 2; gain = gmk + 64; } }
        else { if (pn < 3) { mode = 2; gain = gq; scale = C2; } else if (pn < 6) { mode = 2; gain = gk; } else if (pn == 9) { mode = 2; gain = gmq + 64; scale = C2; } }
        if (mode == 2) {
            f32x4 g[2][2];
#pragma unroll
            for (int bj = 0; bj < 2; ++bj)
#pragma unroll
                for (int n = 0; n < 2; ++n) g[bj][n] = *(const f32x4*)(gain + bj * 32 + 8 * fq + 4 * n) * scale;
#pragma unroll
            for (int ai = 0; ai < 2; ++ai) {
                float rs[4];
#pragma unroll
                for (int k = 0; k < 4; ++k) rs[k] = __shfl(ai ? rp1 : rp0, fr + 16 * k);
#pragma unroll
                for (int m = 0; m < 4; ++m) {
                    const int roff = ai * HALF + m * 16; const float r = rs[m];
                    const f32x4 v00 = acc[ai][0][m][0] * r, v01 = acc[ai][0][m][1] * r, v10 = acc[ai][1][m][0] * r, v11 = acc[ai][1][m][1] * r;
                    const f32x4 sq4 = (v00 * v00 + v01 * v01) + (v10 * v10 + v11 * v11);
                    float ss = (sq4[0] + sq4[1]) + (sq4[2] + sq4[3]);
                    ss += __shfl_xor(ss, 16); ss += __shfl_xor(ss, 32);
                    const float rr = rsqrtf(ss * (1.f / 64.f) + EPS);
                    const f32x4 o00 = v00 * rr * g[0][0], o01 = v01 * rr * g[0][1], o10 = v10 * rr * g[1][0], o11 = v11 * rr * g[1][1];
                    u32x4 w0, w1;
                    w0.x = pk_bf16(o00[0], o00[1]); w0.y = pk_bf16(o00[2], o00[3]); w0.z = pk_bf16(o01[0], o01[1]); w0.w = pk_bf16(o01[2], o01[3]);
                    w1.x = pk_bf16(o10[0], o10[1]); w1.y = pk_bf16(o10[2], o10[3]); w1.z = pk_bf16(o11[0], o11[1]); w1.w = pk_bf16(o11[2], o11[3]);
                    *(u32x4*)(base + (size_t)roff * ld) = w0; *(u32x4*)(base + (size_t)roff * ld + 32) = w1;
                }
            }
        } else {
            const bool gel = mode == 1;
#pragma unroll
            for (int ai = 0; ai < 2; ++ai) {
                float rs[4];
#pragma unroll
                for (int k = 0; k < 4; ++k) rs[k] = __shfl(ai ? rp1 : rp0, fr + 16 * k);
#pragma unroll
                for (int m = 0; m < 4; ++m) {
                    const int roff = ai * HALF + m * 16; const float r = rs[m];
#pragma unroll
                    for (int bj = 0; bj < 2; ++bj) {
                        f32x4 v0 = acc[ai][bj][m][0] * r, v1 = acc[ai][bj][m][1] * r;
                        if (gel) { v0 = gelu4(v0); v1 = gelu4(v1); }
                        u32x4 w; w.x = pk_bf16(v0[0], v0[1]); w.y = pk_bf16(v0[2], v0[3]); w.z = pk_bf16(v1[0], v1[1]); w.w = pk_bf16(v1[2], v1[3]);
                        *(u32x4*)(base + (size_t)roff * ld + bj * 32) = w;
                    }
                }
            }
        }
    }
};

template <class Epi>
__device__ __forceinline__ void gemm_phase(LAS unsigned char* lds, const Gemm g, const Order& S, const Epi& E, const int tid) {
    const int wid = __builtin_amdgcn_readfirstlane(tid >> 6), lane = tid & 63, wr = wid >> 2, wc = wid & 3, fr = lane & 15, fq = lane >> 4;
    const int K = g.K, nt = K / BK;
    unsigned voffA[2], voffB[2];
#pragma unroll
    for (int i = 0; i < 2; ++i) { int R, C; stage_rc(tid * 16 + i * 8192, R, C); const int Rb = (R & ~31) + perm32(R & 31);
        voffA[i] = (unsigned)(R * K + C) * 2u; voffB[i] = (unsigned)(Rb * K + C) * 2u; }
    const size_t kstep = (size_t)(BK * 2);
    const size_t hstep = (size_t)HALF * K * 2;
    const size_t tstep = 2 * hstep;
    const unsigned ldsw = (unsigned)wid * 1024u;
    const int aoff = lds_byte(wr * 64 + fr, fq * 8), boff = lds_byte(wc * 32 + fr, fq * 8);
#define PG8_SA(b, h) (((b) * 2 + (h)) * HTB)
#define PG8_SB(b, h) ((4 + (b) * 2 + (h)) * HTB)
#define PG8_STAGE(bufoff, gbase, voff) do { _Pragma("unroll") for (int _i = 0; _i < 2; ++_i) \
        __builtin_amdgcn_global_load_lds((const unsigned*)((const char*)(gbase) + (voff)[_i]), (LAS unsigned*)(lds + (bufoff) + ldsw + _i * 8192), 16, 0, 0); } while (0)
#define PG8_LDA(dst, b, h) do { _Pragma("unroll") for (int m = 0; m < 4; ++m) _Pragma("unroll") for (int k = 0; k < 2; ++k) dst[m][k] = *(const LAS bf16x8*)(lds + PG8_SA(b, h) + aoff + m * 2048 + k * 1024); } while (0)
#define PG8_LDB(dst, b, h) do { _Pragma("unroll") for (int n = 0; n < 2; ++n) _Pragma("unroll") for (int k = 0; k < 2; ++k) dst[n][k] = *(const LAS bf16x8*)(lds + PG8_SB(b, h) + boff + n * 2048 + k * 1024); } while (0)
#define PG8_MMA(ai, bj, At, Bt) do { __builtin_amdgcn_s_setprio(1); _Pragma("unroll") for (int m = 0; m < 4; ++m) _Pragma("unroll") for (int n = 0; n < 2; ++n) _Pragma("unroll") for (int k = 0; k < 2; ++k) \
        acc[ai][bj][m][n] = __builtin_amdgcn_mfma_f32_16x16x32_bf16(Bt[n][k], At[m][k], acc[ai][bj][m][n], 0, 0, 0); __builtin_amdgcn_s_setprio(0); } while (0)
#define PG8_WAIT_V(n) asm volatile("s_waitcnt vmcnt(" #n ")" ::: "memory")
#define PG8_WAIT_L(n) asm volatile("s_waitcnt lgkmcnt(" #n ")" ::: "memory")
#define PG8_BAR __builtin_amdgcn_s_barrier()
#define PG8_SCHED __builtin_amdgcn_sched_barrier(0)
    Unit cur, nxt; int ui = 0;
    if (!S.next(0, cur)) return;
    float rp0 = 0.f, rp1 = 0.f;
    if constexpr (Epi::NEEDS_RSTD) { const int rr = cur.pm * BM + wr * 64 + fr + 16 * fq; rp0 = row_rstd(E.ssq, rr); rp1 = row_rstd(E.ssq, rr + HALF); }
    f32x4 acc[2][2][4][2];
#pragma unroll
    for (int a = 0; a < 2; ++a)
#pragma unroll
        for (int b = 0; b < 2; ++b)
#pragma unroll
            for (int m = 0; m < 4; ++m)
#pragma unroll
                for (int n = 0; n < 2; ++n) { double zl, zh; asm volatile("v_mov_b64 %0, 0\n\tv_mov_b64 %1, 0" : "=v"(zl), "=v"(zh)); d64x2 zz = {zl, zh}; acc[a][b][m][n] = __builtin_bit_cast(f32x4, zz); }
    bf16x8 At[4][2], B0[2][2], B1[2][2];
    const char* cA = (const char*)g.A + (size_t)cur.pm * tstep; const char* cB = (const char*)g.Bt + (size_t)cur.pn * tstep;
    PG8_STAGE(PG8_SB(0, 0), cB, voffB); PG8_STAGE(PG8_SB(0, 1), cB + hstep, voffB); PG8_STAGE(PG8_SA(0, 0), cA, voffA); PG8_STAGE(PG8_SA(0, 1), cA + hstep, voffA);
    if (wr == 1) PG8_BAR;
    PG8_WAIT_V(2); PG8_BAR;
    PG8_STAGE(PG8_SB(1, 0), cB + kstep, voffB); PG8_STAGE(PG8_SA(1, 0), cA + kstep, voffA); PG8_STAGE(PG8_SB(1, 1), cB + hstep + kstep, voffB);
    PG8_WAIT_V(6); PG8_BAR;
    for (;;) {
        const bool has_next = S.next(ui + 1, nxt);
        const char* nA = has_next ? (const char*)g.A + (size_t)nxt.pm * tstep : cA; const char* nB = has_next ? (const char*)g.Bt + (size_t)nxt.pn * tstep : cB;
        for (int t = 0; t < nt; t += 2) {
            const bool last = (t == nt - 2);
            const char* a1 = cA + (size_t)(t + 1) * kstep;
            const char* a2 = last ? nA : cA + (size_t)(t + 2) * kstep; const char* b2 = last ? nB : cB + (size_t)(t + 2) * kstep;
            const char* a3 = a2 + kstep; const char* b3 = b2 + kstep;
            PG8_LDB(B0, 0, 0); PG8_LDB(B1, 0, 1); PG8_SCHED; PG8_LDA(At, 0, 0); PG8_STAGE(PG8_SA(1, 1), a1 + hstep, voffA);
            PG8_WAIT_V(8); PG8_WAIT_L(0); PG8_BAR; PG8_MMA(0, 0, At, B0); PG8_MMA(0, 1, At, B1); PG8_BAR; PG8_SCHED;
            PG8_LDA(At, 0, 1); PG8_STAGE(PG8_SB(0, 0), b2, voffB); PG8_STAGE(PG8_SB(0, 1), b2 + hstep, voffB); PG8_STAGE(PG8_SA(0, 0), a2, voffA);
            PG8_WAIT_V(8); PG8_WAIT_L(0); PG8_BAR; PG8_MMA(1, 0, At, B0); PG8_MMA(1, 1, At, B1); PG8_BAR; PG8_SCHED;
            PG8_LDB(B0, 1, 0); PG8_LDB(B1, 1, 1); PG8_SCHED; PG8_LDA(At, 1, 0); PG8_STAGE(PG8_SA(0, 1), a2 + hstep, voffA);
            PG8_WAIT_V(8); PG8_WAIT_L(0); PG8_BAR; PG8_MMA(0, 0, At, B0); PG8_MMA(0, 1, At, B1); PG8_BAR; PG8_SCHED;
            PG8_LDA(At, 1, 1); PG8_STAGE(PG8_SB(1, 0), b3, voffB); PG8_STAGE(PG8_SB(1, 1), b3 + hstep, voffB); PG8_STAGE(PG8_SA(1, 0), a3, voffA);
            PG8_WAIT_V(8); PG8_WAIT_L(0); PG8_BAR; PG8_MMA(1, 0, At, B0); PG8_MMA(1, 1, At, B1); PG8_BAR; PG8_SCHED;
        }
        f32x4 raw0, raw1;
        if constexpr (Epi::NEEDS_RSTD) { const int rr = (has_next ? nxt.pm : cur.pm) * BM + wr * 64 + fr + 16 * fq;
            raw0 = *(const f32x4*)(E.ssq + (size_t)rr * 4); raw1 = *(const f32x4*)(E.ssq + (size_t)(rr + HALF) * 4); }
        if (wr == 0) PG8_BAR;
        float rn0 = 0.f, rn1 = 0.f;
        E(acc, cur, wr, wc, fr, fq, rp0, rp1, raw0, raw1, rn0, rn1);
        if constexpr (Epi::NEEDS_RSTD && !Epi::EARLY_RSTD) rstd_finish(raw0, raw1, rn0, rn1);
        rp0 = rn0; rp1 = rn1;
        if (!has_next) break;
#pragma unroll
        for (int a = 0; a < 2; ++a)
#pragma unroll
            for (int b = 0; b < 2; ++b)
#pragma unroll
                for (int m = 0; m < 4; ++m)
#pragma unroll
                    for (int n = 0; n < 2; ++n) { double zl, zh; asm volatile("v_mov_b64 %0, 0\n\tv_mov_b64 %1, 0" : "=v"(zl), "=v"(zh)); d64x2 zz = {zl, zh}; acc[a][b][m][n] = __builtin_bit_cast(f32x4, zz); }
        cur = nxt; cA = nA; cB = nB; ++ui;
        if (wr == 1) PG8_BAR;
    }
    PG8_WAIT_V(0);
    PG8_BAR;
#undef PG8_SA
#undef PG8_SB
#undef PG8_STAGE
#undef PG8_LDA
#undef PG8_LDB
#undef PG8_MMA
#undef PG8_WAIT_V
#undef PG8_WAIT_L
#undef PG8_BAR
#undef PG8_SCHED
}
}

struct TrDesc { const float* W; int K, N; bf16_t* WT; const float* gain; int k0, n0, drow0; };
__device__ __forceinline__ void tr_loads(const TrDesc& d, float (&wv)[32], int lane) {
#pragma unroll
    for (int i = 0; i < 32; ++i) wv[i] = d.W[(size_t)(d.k0 + 2 * i + (lane >> 5)) * d.N + d.n0 + (lane & 31)];
}
__device__ __forceinline__ void tr_finish(const TrDesc& d, float (&wv)[32], LAS float* scr, int lane) {
    if (d.gain) {
#pragma unroll
        for (int i = 0; i < 32; ++i) wv[i] *= d.gain[d.k0 + 2 * i + (lane >> 5)];
    }
#pragma unroll
    for (int i = 0; i < 32; ++i) scr[(2 * i + (lane >> 5)) * 33 + (lane & 31)] = wv[i];
    asm volatile("s_waitcnt lgkmcnt(0)" ::: "memory");
    const int c = lane & 7;
#pragma unroll
    for (int j = 0; j < 4; ++j) { const int n = (lane >> 3) + 8 * j; const LAS float* s = scr + (8 * c) * 33 + n;
        u32x4 o; o.x = pk_bf16(s[0 * 33], s[1 * 33]); o.y = pk_bf16(s[2 * 33], s[3 * 33]); o.z = pk_bf16(s[4 * 33], s[5 * 33]); o.w = pk_bf16(s[6 * 33], s[7 * 33]);
        *(u32x4*)(d.WT + (size_t)(d.drow0 + n) * d.K + d.k0 + 8 * c) = o; }
    asm volatile("s_waitcnt lgkmcnt(0)" ::: "memory");
}
__device__ __forceinline__ void row_to_bf16(const float* xrow, bf16_t* orow, float* ssqrow, int lane) {
    const f32x4* xr = (const f32x4*)xrow + lane;
    f32x4 v[4]; float s = 0.f;
#pragma unroll
    for (int j = 0; j < 4; ++j) { v[j] = xr[64 * j]; s += (v[j].x * v[j].x + v[j].y * v[j].y) + (v[j].z * v[j].z + v[j].w * v[j].w); }
    s = wave_sum(s);
    u32x2* o8 = (u32x2*)orow + lane;
#pragma unroll
    for (int j = 0; j < 4; ++j) { u32x2 w; w.x = pk_bf16(v[j].x, v[j].y); w.y = pk_bf16(v[j].z, v[j].w); o8[64 * j] = w; }
    if (lane < 16) ssqrow[lane] = lane == 0 ? s : 0.f;
}

struct Params { const float* in[20]; float* out; unsigned char* ws; };
__device__ __forceinline__ int mixrow(int n0) { const int l = n0 & 255; return (n0 & ~255) + ((l >> 5) & 1) * 128 + (l >> 6) * 32; }

__device__ __forceinline__ void prologue(const Params& p, LAS unsigned char* lds, int gw, int NGW, int wave, int lane) {
    LAS float* scr = (LAS float*)(lds + wave * 16384);
    unsigned char* ws = p.ws;
    constexpr int I_FFIN = 16 * 176, I_FFOUT = 44 * 32, I_MIX0 = 16 * 56, I_KV = 16 * 16, I_MIX1 = 16 * 80, I_WO = 16 * 32;
    constexpr int C0 = 4 * I_FFIN, C1 = C0 + 4 * I_FFOUT, C2_ = C1 + I_MIX0, C3 = C2_ + 2 * I_KV, C4 = C3 + I_MIX1, C5 = C4 + 2 * I_WO;
    for (int it0 = gw; it0 < C5; it0 += 2 * NGW) {
        TrDesc ds[2];
#pragma unroll
        for (int q = 0; q < 2; ++q) {
            const int it = min(it0 + q * NGW, C5 - 1); TrDesc& d = ds[q];
            if (it < C0) {
                const int mat = it / I_FFIN, r = it % I_FFIN, kb = r / 176, nb = r % 176, n0 = nb * 32;
                const int j = n0 < FF ? n0 : n0 - FF; const int drow0 = (j >> 7) * 256 + (n0 < FF ? 0 : 128) + (j & 127);
                d = TrDesc{p.in[3] + (size_t)mat * DM * 2 * FF, DM, 2 * FF, (bf16_t*)(ws + WS_WFFIN + mat * SZ_WFFIN), p.in[2] + mat * DM, kb * 64, n0, drow0};
            } else if (it < C1) {
                const int r0 = it - C0, mat = r0 / I_FFOUT, r = r0 % I_FFOUT, kb = r / 32, nb = r % 32;
                d = TrDesc{p.in[4] + (size_t)mat * FF * DM, FF, DM, (bf16_t*)(ws + WS_WFFOUT + mat * SZ_WFFOUT), nullptr, kb * 64, nb * 32, nb * 32};
            } else if (it < C2_) {
                const int r = it - C1, kb = r / 56, nb = r % 56;
                d = TrDesc{p.in[11], DM, NMIX0, (bf16_t*)(ws + WS_WMIX0), p.in[5], kb * 64, nb * 32, mixrow(nb * 32)};
            } else if (it < C3) {
                const int r0 = it - C2_, l = r0 / I_KV, r = r0 % I_KV, kb = r / 16, nb = r % 16;
                d = TrDesc{p.in[7] + (size_t)l * DM * 512, DM, 512, (bf16_t*)(ws + WS_WMIX0), p.in[6] + l * DM, kb * 64, nb * 32, NMIX0 + l * 512 + mixrow(nb * 32)};
            } else if (it < C4) {
                const int r = it - C3, kb = r / 80, nb = r % 80;
                d = TrDesc{p.in[15], DM, NMIX1, (bf16_t*)(ws + WS_WMIX1), p.in[5] + DM, kb * 64, nb * 32, mixrow(nb * 32)};
            } else {
                const int r0 = it - C4, l = r0 / I_WO, r = r0 % I_WO, kb = r / 32, nb = r % 32;
                d = TrDesc{p.in[10] + (size_t)l * DM * DM, DM, DM, (bf16_t*)(ws + WS_WO + (size_t)l * DM * DM * 2), nullptr, kb * 64, nb * 32, nb * 32};
            }
        }
        float wa[32], wb[32];
        tr_loads(ds[0], wa, lane); tr_loads(ds[1], wb, lane);
        tr_finish(ds[0], wa, scr, lane); tr_finish(ds[1], wb, scr, lane);
    }
    {
        const int gt = gw * 64 + lane;
        if (gt < 6 * 128 * 16) {
            const int row = gt >> 4, seg = gt & 15, t = row & 127;
            const float* s = p.in[13] + (size_t)row * 128 + seg * 8;
            f32x4 a = *(const f32x4*)s, b = *(const f32x4*)(s + 4);
#pragma unroll
            for (int j = 0; j < 4; ++j) { if (seg * 8 + j > t) a[j] = 0.f; if (seg * 8 + 4 + j > t) b[j] = 0.f; }
            u32x4 o; o.x = pk_bf16(a[0], a[1]); o.y = pk_bf16(a[2], a[3]); o.z = pk_bf16(b[0], b[1]); o.w = pk_bf16(b[2], b[3]);
            *(u32x4*)((bf16_t*)(ws + WS_WSB) + (size_t)row * 128 + seg * 8) = o;
        }
    }
    bf16_t* xb = (bf16_t*)(ws + WS_XB); float* ssq = (float*)(ws + WS_SSQ);
    for (int m = gw; m < AROWS; m += 2 * NGW) {
        const int m2 = m + NGW; const bool two = m2 < AROWS;
        const float* s1 = m < T ? p.in[0] + (size_t)m * DM : p.in[1] + (size_t)(m - T) * DM;
        const float* s2 = !two ? s1 : (m2 < T ? p.in[0] + (size_t)m2 * DM : p.in[1] + (size_t)(m2 - T) * DM);
        const f32x4* x1 = (const f32x4*)s1 + lane; const f32x4* x2 = (const f32x4*)s2 + lane;
        f32x4 a[4], b[4];
#pragma unroll
        for (int j = 0; j < 4; ++j) { a[j] = x1[64 * j]; b[j] = x2[64 * j]; }
        float sa = 0.f, sb = 0.f;
#pragma unroll
        for (int j = 0; j < 4; ++j) { sa += (a[j].x * a[j].x + a[j].y * a[j].y) + (a[j].z * a[j].z + a[j].w * a[j].w); sb += (b[j].x * b[j].x + b[j].y * b[j].y) + (b[j].z * b[j].z + b[j].w * b[j].w); }
        sa = wave_sum(sa); sb = wave_sum(sb);
        u32x2* o1 = (u32x2*)(xb + (size_t)m * DM) + lane;
#pragma unroll
        for (int j = 0; j < 4; ++j) { u32x2 w; w.x = pk_bf16(a[j].x, a[j].y); w.y = pk_bf16(a[j].z, a[j].w); o1[64 * j] = w; }
        if (lane < 4) ssq[(size_t)m * 4 + lane] = lane == 0 ? sa : 0.f;
        if (two) {
            u32x2* o2 = (u32x2*)(xb + (size_t)m2 * DM) + lane;
#pragma unroll
            for (int j = 0; j < 4; ++j) { u32x2 w; w.x = pk_bf16(b[j].x, b[j].y); w.y = pk_bf16(b[j].z, b[j].w); o2[64 * j] = w; }
            if (lane < 4) ssq[(size_t)m2 * 4 + lane] = lane == 0 ? sb : 0.f;
        }
    }
}

#define MFMA32(a, b, c) __builtin_amdgcn_mfma_f32_32x32x16_bf16((a), (b), (c), 0, 0, 0)
__device__ __forceinline__ bf16x8 vtr8(LAS const char* p, int hi_off) {
    const s16x4 lo = __builtin_amdgcn_ds_read_tr16_b64_v4i16((LAS s16x4*)p);
    const s16x4 hi = __builtin_amdgcn_ds_read_tr16_b64_v4i16((LAS s16x4*)(p + hi_off));
    return __builtin_shufflevector(lo, hi, 0, 1, 2, 3, 4, 5, 6, 7);
}
__device__ __forceinline__ bf16x8 pack8(const f32x16& x, int s) {
    u32x4 p; p.x = pk_bf16(x[8 * s], x[8 * s + 1]); p.y = pk_bf16(x[8 * s + 2], x[8 * s + 3]); p.z = pk_bf16(x[8 * s + 4], x[8 * s + 5]); p.w = pk_bf16(x[8 * s + 6], x[8 * s + 7]);
    return __builtin_bit_cast(bf16x8, p);
}
constexpr int ATT_KP = 272, ATT_VP = 320, ATT_KBUF = 64 * ATT_KP, ATT_VBUF = 64 * ATT_VP, ATT_VOFF = 2 * ATT_KBUF;

__device__ __forceinline__ float xor32_max(float m) {
    auto rr = __builtin_amdgcn_permlane32_swap(__float_as_uint(m), __float_as_uint(m), false, false);
    return fmaxf(__uint_as_float(rr[0]), __uint_as_float(rr[1]));
}
__device__ __forceinline__ float xor32_sum(float m) {
    auto rr = __builtin_amdgcn_permlane32_swap(__float_as_uint(m), __float_as_uint(m), false, false);
    return __uint_as_float(rr[0]) + __uint_as_float(rr[1]);
}
template <bool DIFF, int NDV>
__device__ __forceinline__ void attn_tile(f32x16 (&o)[NDV], float& l, const bf16x8 (&qf)[4], const float sref, LAS const char* kc, LAS const char* vc,
                                          bool masked, int kb0, int qrow) {
    bf16x8 kf[8];
#pragma unroll
    for (int ks = 0; ks < 4; ++ks) { kf[2 * ks] = *(LAS const bf16x8*)(kc + ks * 32); kf[2 * ks + 1] = *(LAS const bf16x8*)(kc + 32 * ATT_KP + ks * 32); }
    f32x16 s0, s1;
#pragma unroll
    for (int i = 0; i < 16; ++i) { s0[i] = 0.f; s1[i] = 0.f; }
#pragma unroll
    for (int ks = 0; ks < 4; ++ks) { s0 = MFMA32(kf[2 * ks], qf[ks], s0); s1 = MFMA32(kf[2 * ks + 1], qf[ks], s1); }
    __builtin_amdgcn_sched_barrier(0);
    bf16x8 vf[8];
#pragma unroll
    for (int d = 0; d < 2; ++d)
#pragma unroll
        for (int kk = 0; kk < 4; ++kk) vf[d * 4 + kk] = vtr8(vc + kk * 16 * ATT_VP + d * 64, 8 * ATT_VP);
    __builtin_amdgcn_sched_barrier(0);
    if (DIFF && masked) {
#pragma unroll
        for (int i = 0; i < 16; ++i) { const int key = kb0 + (i & 3) + 8 * (i >> 2); if (key > qrow) s0[i] = -1e30f; if (key + 32 > qrow) s1[i] = -1e30f; }
    }
    if (sref != 0.f) {
#pragma unroll
        for (int i = 0; i < 16; ++i) { s0[i] -= sref; s1[i] -= sref; }
    }
    float rs = 0.f;
#pragma unroll
    for (int i = 0; i < 16; ++i) { s0[i] = fast_exp2(s0[i]); s1[i] = fast_exp2(s1[i]); rs += s0[i] + s1[i]; }
    l += rs;
    bf16x8 pb[4];
    pb[0] = pack8(s0, 0); pb[1] = pack8(s0, 1); pb[2] = pack8(s1, 0); pb[3] = pack8(s1, 1);
    if (NDV == 4) {
        bf16x8 vf2[8];
#pragma unroll
        for (int d = 0; d < 2; ++d)
#pragma unroll
            for (int kk = 0; kk < 4; ++kk) vf2[d * 4 + kk] = vtr8(vc + kk * 16 * ATT_VP + (d + 2) * 64, 8 * ATT_VP);
        __builtin_amdgcn_sched_barrier(0);
#pragma unroll
        for (int kk = 0; kk < 4; ++kk) { o[0] = MFMA32(vf[kk], pb[kk], o[0]); o[1] = MFMA32(vf[4 + kk], pb[kk], o[1]); }
#pragma unroll
        for (int kk = 0; kk < 4; ++kk) { o[2] = MFMA32(vf2[kk], pb[kk], o[2]); o[NDV - 1] = MFMA32(vf2[4 + kk], pb[kk], o[NDV - 1]); }
    } else {
#pragma unroll
        for (int kk = 0; kk < 4; ++kk) { o[0] = MFMA32(vf[kk], pb[kk], o[0]); o[1] = MFMA32(vf[4 + kk], pb[kk], o[1]); }
    }
}

template <bool DIFF>
__device__ __forceinline__ void attn_unit(LAS unsigned char* lds, const bf16_t* Qp, int ldq, const bf16_t* Kp, const bf16_t* Vp, int ldkv,
                                          bf16_t* Op, int qb, float lam, const float* subln, const float sbound, const int tid) {
    constexpr int NDV = DIFF ? 4 : 2;
    const int w = __builtin_amdgcn_readfirstlane(tid >> 6), lane = tid & 63, r = lane & 31, h = lane >> 5, c = w >> 2, sq = w & 3;
    const int nkt = DIFF ? 2 * qb + 2 : 4;
    const int my_last = DIFF ? ((qb * 128 + sq * 32 + 31) >> 6) : 3;
    const int qrow = qb * 128 + sq * 32 + r;
    bf16x8 qf[4];
    { const bf16_t* qptr = Qp + (size_t)(sq * 32 + r) * ldq + c * 64 + 8 * h;
#pragma unroll
      for (int ks = 0; ks < 4; ++ks) qf[ks] = *(const bf16x8*)(qptr + 16 * ks); }
    const int srow = tid >> 4, sseg = tid & 15;
    const bf16_t* kg = Kp + (size_t)srow * ldkv + sseg * 8;
    const bf16_t* vg = Vp + (size_t)srow * ldkv + sseg * 8;
    const size_t g32 = (size_t)32 * ldkv, g64 = (size_t)64 * ldkv;
    LAS unsigned char* kw = lds + srow * ATT_KP + sseg * 16;
    LAS unsigned char* vw = lds + ATT_VOFF + srow * ATT_VP + sseg * 16;
    u32x4 ra[4], rb[4], rc[4];
#define ATT_LOAD(R, kti) do { const bf16_t* _k = kg + (size_t)(kti) * g64; const bf16_t* _v = vg + (size_t)(kti) * g64; \
        R[0] = *(const u32x4*)_k; R[1] = *(const u32x4*)(_k + g32); R[2] = *(const u32x4*)_v; R[3] = *(const u32x4*)(_v + g32); } while (0)
#define ATT_WRITE(R, buf) do { LAS unsigned char* _k = kw + (buf) * ATT_KBUF; LAS unsigned char* _v = vw + (buf) * ATT_VBUF; \
        *(LAS u32x4*)_k = R[0]; *(LAS u32x4*)(_k + 32 * ATT_KP) = R[1]; *(LAS u32x4*)_v = R[2]; *(LAS u32x4*)(_v + 32 * ATT_VP) = R[3]; } while (0)
    ATT_LOAD(ra, 0);
    ATT_LOAD(rb, 1);
    ATT_LOAD(rc, min(2, nkt - 1));
    ATT_WRITE(ra, 0);
    f32x16 o[NDV];
#pragma unroll
    for (int d = 0; d < NDV; ++d)
#pragma unroll
        for (int i = 0; i < 16; ++i) o[d][i] = 0.f;
    float l = 0.f;
    const float sref = fmaxf(sbound - 64.f, 0.f);
    asm volatile("" :: "v"(qf[0]), "v"(qf[1]), "v"(qf[2]), "v"(qf[3]));
    __syncthreads();
    LAS const char* kb = (LAS const char*)lds + r * ATT_KP + (c * 64 + 8 * h) * 2;
    const int q4 = (lane & 15) >> 2, p4 = lane & 3, blk = (lane >> 4) & 1;
    LAS const char* vb = (LAS const char*)lds + ATT_VOFF + (4 * h + q4) * ATT_VP + ((DIFF ? 0 : c * 64) + 16 * blk) * 2 + 8 * p4;
    const int q0w = qb * 128 + sq * 32;
#define ATT_STEP(kti, LD, WR) do { \
        ATT_LOAD(LD, min((kti) + 3, nkt - 1));     \
        if ((kti) <= my_last) attn_tile<DIFF, NDV>(o, l, qf, sref, kb + ((kti) & 1) * ATT_KBUF, vb + ((kti) & 1) * ATT_VBUF, (kti) * 64 + 63 > q0w, (kti) * 64 + 4 * h, qrow); \
        if ((kti) + 1 < nkt) ATT_WRITE(WR, ((kti) + 1) & 1); \
        __syncthreads(); } while (0)
#pragma unroll 1
    for (int kt = 0; kt < nkt; kt += 3) {
        ATT_STEP(kt, ra, rb);
        if (kt + 1 >= nkt) break;
        ATT_STEP(kt + 1, rb, rc);
        if (kt + 2 >= nkt) break;
        ATT_STEP(kt + 2, rc, ra);
    }
#undef ATT_STEP
#undef ATT_LOAD
#undef ATT_WRITE
    l = xor32_sum(l);
    const float inv = 1.f / l;
    if (!DIFF) {
        bf16_t* orow = Op + (size_t)(sq * 32 + r) * DM + c * 64 + 4 * h;
#pragma unroll
        for (int d = 0; d < NDV; ++d)
#pragma unroll
            for (int g = 0; g < 4; ++g) {
                u32x2 wv; wv.x = pk_bf16(o[d][4 * g] * inv, o[d][4 * g + 1] * inv); wv.y = pk_bf16(o[d][4 * g + 2] * inv, o[d][4 * g + 3] * inv);
                *(u32x2*)(orow + d * 32 + 8 * g) = wv;
            }
    } else {
        LAS float* ex = (LAS float*)lds + sq * 4096 + lane;
        f32x4 gn[16];
        if (c == 0) {
#pragma unroll
            for (int d = 0; d < NDV; ++d)
#pragma unroll
                for (int g = 0; g < 4; ++g) gn[d * 4 + g] = *(const f32x4*)(subln + d * 32 + 8 * g + 4 * h);
        }
        if (c == 1) {
            const float sc = lam * inv;
#pragma unroll
            for (int d = 0; d < NDV; ++d)
#pragma unroll
                for (int i = 0; i < 16; ++i) ex[(d * 16 + i) * 64] = o[d][i] * sc;
        }
        __syncthreads();
        if (c == 0) {
            float ss = 0.f;
#pragma unroll
            for (int d = 0; d < NDV; ++d)
#pragma unroll
                for (int i = 0; i < 16; ++i) { const float v = o[d][i] * inv - ex[(d * 16 + i) * 64]; o[d][i] = v; ss += v * v; }
            ss = xor32_sum(ss);
            const float rr = rsqrtf(ss * (1.f / 128.f) + EPS) * (1.f - LAMBDA_INIT);
            bf16_t* orow = Op + (size_t)(sq * 32 + r) * DM + 4 * h;
#pragma unroll
            for (int d = 0; d < NDV; ++d)
#pragma unroll
                for (int g = 0; g < 4; ++g) {
                    const f32x4 gv = gn[d * 4 + g];
                    u32x2 wv; wv.x = pk_bf16(o[d][4 * g] * rr * gv[0], o[d][4 * g + 1] * rr * gv[1]); wv.y = pk_bf16(o[d][4 * g + 2] * rr * gv[2], o[d][4 * g + 3] * rr * gv[3]);
                    *(u32x2*)(orow + d * 32 + 8 * g) = wv;
                }
        }
        __syncthreads();
    }
}

struct GmlpRegs { u32x4 v[4]; u32x2 uv[8]; u32x4 w[8]; float bias; };
__device__ __forceinline__ void gmlp_load(GmlpRegs& R, const bf16_t* zb, const bf16_t* wsb, const float* bsall, int u, int tid, int t, int h, int cb0) {
    const int b = u / 96, rem = u % 96, n = rem / 6, g = rem % 6;
    const bf16_t* zrows = zb + ((size_t)b * SEQ + n * 128) * NMIX0;
    const bf16_t* urow = zrows + (size_t)t * NMIX0 + g * 128 + 4 * h;
#pragma unroll
    for (int i = 0; i < 8; ++i) R.uv[i] = *(const u32x2*)(urow + (cb0 + (i >> 2)) * 32 + 8 * (i & 3));
    const bf16_t* wrow = wsb + (size_t)g * 128 * 128 + (size_t)t * 128 + 8 * h;
#pragma unroll
    for (int i = 0; i < 8; ++i) R.w[i] = *(const u32x4*)(wrow + 16 * i);
    R.bias = bsall[g * 128 + t];
    const bf16_t* vgp = zrows + (size_t)(tid >> 2) * NMIX0 + 768 + g * 128 + (tid & 3) * 32;
#pragma unroll
    for (int j = 0; j < 4; ++j) R.v[j] = *(const u32x4*)(vgp + 8 * j);
}
__device__ __forceinline__ void gmlp_compute(LAS unsigned char* lds, const GmlpRegs& R, bf16_t* cat, int u, int tid, int lane, int t, int h, int cb0) {
    constexpr int VP = 320, GOFF = 49152;
    const int b = u / 96, rem = u % 96, n = rem / 6, g = rem % 6;
    {
        const int row = tid >> 2, qtr = tid & 3;
        float ss = 0.f;
#pragma unroll
        for (int j = 0; j < 4; ++j)
#pragma unroll
            for (int e = 0; e < 4; ++e) { const float x = bf_lo(R.v[j][e]), y = bf_hi(R.v[j][e]); ss += x * x + y * y; }
        ss += __shfl_xor(ss, 1); ss += __shfl_xor(ss, 2);
        const float rs = rsqrtf(ss * (1.f / 128.f) + EPS);
        LAS const unsigned char* gp = lds + GOFF + (g * 128 + qtr * 32) * 4;
        LAS unsigned char* dst = lds + row * VP + qtr * 64;
#pragma unroll
        for (int j = 0; j < 4; ++j) {
            const f32x4 g0 = *(LAS const f32x4*)(gp + 32 * j), g1 = *(LAS const f32x4*)(gp + 32 * j + 16);
            u32x4 o;
            o.x = pk_bf16(bf_lo(R.v[j].x) * rs * g0[0], bf_hi(R.v[j].x) * rs * g0[1]); o.y = pk_bf16(bf_lo(R.v[j].y) * rs * g0[2], bf_hi(R.v[j].y) * rs * g0[3]);
            o.z = pk_bf16(bf_lo(R.v[j].z) * rs * g1[0], bf_hi(R.v[j].z) * rs * g1[1]); o.w = pk_bf16(bf_lo(R.v[j].w) * rs * g1[2], bf_hi(R.v[j].w) * rs * g1[3]);
            *(LAS u32x4*)(dst + 16 * j) = o;
        }
    }
    __syncthreads();
    const int q4 = (lane & 15) >> 2, p4 = lane & 3, blk = (lane >> 4) & 1;
    LAS const char* vb = (LAS const char*)lds + (8 * h + q4) * VP + (cb0 * 32 + 16 * blk) * 2 + 8 * p4;
    f32x16 a0, a1;
#pragma unroll
    for (int i = 0; i < 16; ++i) { a0[i] = 0.f; a1[i] = 0.f; }
#pragma unroll
    for (int ks = 0; ks < 8; ++ks) {
        const bf16x8 wf = __builtin_bit_cast(bf16x8, R.w[ks]);
        const bf16x8 v0 = vtr8(vb + ks * 16 * VP, 4 * VP), v1 = vtr8(vb + ks * 16 * VP + 64, 4 * VP);
        a0 = MFMA32(v0, wf, a0); a1 = MFMA32(v1, wf, a1);
    }
    bf16_t* orow = cat + ((size_t)b * SEQ + n * 128 + t) * DM + g * 128 + 4 * h;
    const float bias = R.bias;
#pragma unroll
    for (int cbi = 0; cbi < 2; ++cbi)
#pragma unroll
        for (int gq = 0; gq < 4; ++gq) {
            const int c0 = (cb0 + cbi) * 32 + 8 * gq;
            const u32x2 uu = R.uv[cbi * 4 + gq];
            const f32x16& a = cbi ? a1 : a0;
            u32x2 wv; wv.x = pk_bf16(bf_lo(uu.x) * (a[4 * gq] + bias), bf_hi(uu.x) * (a[4 * gq + 1] + bias));
            wv.y = pk_bf16(bf_lo(uu.y) * (a[4 * gq + 2] + bias), bf_hi(uu.y) * (a[4 * gq + 3] + bias));
            *(u32x2*)(orow + c0) = wv;
        }
    __syncthreads();
}
__device__ __forceinline__ void gmlp_phase(LAS unsigned char* lds, const bf16_t* zb, const bf16_t* wsb, const float* bsall, const float* vgall, bf16_t* cat, int vcu, int G, const int tid) {
    constexpr int GOFF = 49152;
    if (vcu >= 1536) return;
    if (tid < 192) *(LAS f32x4*)(lds + GOFF + tid * 16) = *(const f32x4*)(vgall + tid * 4);
    const int w = __builtin_amdgcn_readfirstlane(tid >> 6), lane = tid & 63, r = lane & 31, h = lane >> 5;
    const int tb = w & 3, cb0 = (w >> 2) * 2; int t = 32 * tb + r; asm volatile("" : "+v"(t));
    int u = vcu;
    GmlpRegs A; gmlp_load(A, zb, wsb, bsall, u, tid, t, h, cb0);
    __syncthreads();
#pragma unroll 1
    for (;;) {
        const int un = u + G; const bool hn = un < 1536;
        GmlpRegs B; gmlp_load(B, zb, wsb, bsall, hn ? un : u, tid, t, h, cb0);
        gmlp_compute(lds, A, cat, u, tid, lane, t, h, cb0);
        if (!hn) break;
        A = B; u = un;
    }
}

#define XB_TMO      128
#define XB_XCNT(j)  (256  + 64 * (j))
#define XB_XSUB(j)  (1280 + 64 * (j))
#define XB_XGEN(j)  (2304 + 64 * (j))
#define XB_TOP      3328
#define XB_TOPGEN   3392
#define XCD_BAR_WORDS 3456
#define XB_SPIN_CAP (1u << 20)
__device__ __forceinline__ unsigned xb_ld(unsigned* p)              { return __hip_atomic_load(p, __ATOMIC_RELAXED, __HIP_MEMORY_SCOPE_AGENT); }
__device__ __forceinline__ unsigned xb_add(unsigned* p, unsigned v) { return __hip_atomic_fetch_add(p, v, __ATOMIC_RELAXED, __HIP_MEMORY_SCOPE_AGENT); }
__device__ __forceinline__ unsigned xb_xcc_id() { return (unsigned)__builtin_amdgcn_s_getreg((3 << 11) | 20) & 0xFu; }
#define XB_SPIN(cond, bar) do { unsigned _sp = 0; while (cond) { __builtin_amdgcn_s_sleep(1); \
    if ((++_sp & 255u) == 0u) { if (xb_ld(&(bar)[XB_TMO])) break; if (_sp > XB_SPIN_CAP) { atomicAdd(&(bar)[XB_TMO], 1u); break; } } } } while (0)
struct XcdBarrier { unsigned* bar; unsigned x; volatile LAS unsigned* st; };
__device__ __forceinline__ XcdBarrier xcd_barrier_post(unsigned* bar, volatile LAS unsigned* st, const int tid) {
    XcdBarrier b; b.bar = bar; b.x = xb_xcc_id(); b.st = st;
    if (tid == 0) (void)xb_add(&bar[XB_XCNT(b.x)], 1u);
    return b;
}
__device__ __forceinline__ void xcd_barrier_complete(unsigned* bar, unsigned x, unsigned& nloc, unsigned& nx) {
    const unsigned G = gridDim.x * gridDim.y * gridDim.z;
    unsigned sum, cnt, mine, sp = 0u;
    for (;;) {
        sum = 0u; cnt = 0u; mine = 0u;
#pragma unroll
        for (unsigned j = 0; j < 16; ++j) { const unsigned c = xb_ld(&bar[XB_XCNT(j)]); sum += c; cnt += (c > 0u) ? 1u : 0u; mine = (j == x) ? c : mine; }
        if (sum == G) break;
        __builtin_amdgcn_s_sleep(1);
        if ((++sp & 255u) == 0u) { if (xb_ld(&bar[XB_TMO])) break; if (sp > XB_SPIN_CAP) { atomicAdd(&bar[XB_TMO], 1u); break; } }
    }
    nloc = mine > 0u ? mine : 1u; nx = cnt > 0u ? cnt : 1u;
}
__device__ __forceinline__ void xcd_barrier(const XcdBarrier& b, const int tid) {
    asm volatile("s_waitcnt vmcnt(0)" ::: "memory");
    __syncthreads();
    if (tid == 0) {
        unsigned* bar = b.bar;
        __builtin_amdgcn_s_waitcnt(0);
        unsigned nloc = b.st[0], nx = b.st[1];
        if (nloc == 0u) { xcd_barrier_complete(bar, b.x, nloc, nx); b.st[0] = nloc; b.st[1] = nx; }
        const unsigned old = xb_add(&bar[XB_XSUB(b.x)], 1u);
        const unsigned gen = old / nloc;
        if (old + 1u == (gen + 1u) * nloc) {
            __builtin_amdgcn_fence(__ATOMIC_RELEASE, "agent");
            asm volatile("s_waitcnt vmcnt(0)" ::: "memory");
            const unsigned og = xb_add(&bar[XB_TOP], 1u);
            const unsigned tg = og / nx;
            if (og + 1u == (tg + 1u) * nx) xb_add(&bar[XB_TOPGEN], 1u);
            else XB_SPIN(xb_ld(&bar[XB_TOPGEN]) == tg, bar);
            __builtin_amdgcn_fence(__ATOMIC_ACQUIRE, "agent");
            xb_add(&bar[XB_XGEN(b.x)], 1u);
            asm volatile("s_waitcnt vmcnt(0)" ::: "memory");
        } else {
            XB_SPIN(xb_ld(&bar[XB_XGEN(b.x)]) == gen, bar);
            __builtin_amdgcn_fence(__ATOMIC_ACQUIRE, "agent");
            asm volatile("s_waitcnt vmcnt(0)" ::: "memory");
        }
    }
    __syncthreads();
}

#define PHASE_SEQ 0, 1, 2, 3, 5, 6, 7, 8, 9, 10, 11, 13, 14, 15, 16
__constant__ unsigned char phase_seq[] = {PHASE_SEQ};
constexpr int N_PHASES = sizeof(phase_seq);
__global__ void __launch_bounds__(512, 2) fwd_megakernel(Params p_, int ph_lo, int ph_hi) {
    extern __shared__ __attribute__((aligned(16))) unsigned char lds_raw[];
    LAS unsigned char* lds = (LAS unsigned char*)lds_raw;
    cg::grid_group grid = cg::this_grid();
    volatile LAS unsigned* bst = (volatile LAS unsigned*)(lds + 131072 + 512);
    if (threadIdx.x < 2) bst[threadIdx.x] = 0u;
    unsigned* barw = (unsigned*)(p_.ws + WS_BAR);
    if (blockIdx.x == 0) for (int i = threadIdx.x; i < XCD_BAR_WORDS; i += 512) barw[i] = 0u;
    XcdBarrier xbar; xbar.bar = barw; xbar.x = 0; xbar.st = bst;
#pragma unroll 1
    for (int phi = ph_lo; phi < ph_hi; ++phi) {
        const int ph = phase_seq[phi];
        int tid = threadIdx.x; asm volatile("" : "+v"(tid));
        unsigned long long kab = (unsigned long long)__builtin_amdgcn_kernarg_segment_ptr(); asm volatile("" : "+s"(kab));
        const Params& p = *(const Params*)(const __attribute__((address_space(4))) char*)kab;
        const int lane = tid & 63, wave = __builtin_amdgcn_readfirstlane(tid >> 6);
        int G = gridDim.x, bx = blockIdx.x; asm volatile("" : "+s"(G), "+s"(bx));
        unsigned char* ws = p.ws;
        bf16_t* xb = (bf16_t*)(ws + WS_XB); bf16_t* act = (bf16_t*)(ws + WS_ACT); bf16_t* zb = act; bf16_t* cat = (bf16_t*)(ws + WS_CAT);
        bf16_t* memkv = (bf16_t*)(ws + WS_MEMKV); float* ssq = (float*)(ws + WS_SSQ);
        float* X = p.out;
        if (ph == 0) {
            prologue(p, lds, bx * 8 + wave, G * 8, wave, lane);
        } else if (ph < 17) {
            const int q = ph - 1, layer = q >> 3, s = q & 7;
            const int ldz = layer == 0 ? NMIX0 : NMIX1, qmoff = layer == 0 ? 1536 : 2304;
            if (s == 0 || s == 6) {
                const int mat = layer * 2 + (s == 6);
                pg8::Gemm g{xb, (const bf16_t*)(ws + WS_WFFIN + mat * SZ_WFFIN), T, 2 * FF, DM};
                pg8::Order S; S.init(T, 2 * FF, G, bx);
                pg8::EpiSwiglu E{act, ssq};
                pg8::gemm_phase<pg8::EpiSwiglu>(lds, g, S, E, tid);
            } else if (s == 1 || s == 7 || s == 5) {
                const int mat = layer * 2 + (s == 7);
                const bool op = s == 5;
                pg8::Gemm g{op ? cat : act, (const bf16_t*)(ws + (op ? WS_WO + (size_t)layer * DM * DM * 2 : WS_WFFOUT + mat * SZ_WFFOUT)), T, DM, op ? DM : FF};
                pg8::Order S; S.init(T, DM, G, bx);
                pg8::EpiResid E{xb, ph == 16 ? X : nullptr, ssq, op ? 1.f : 0.5f, (LAS float*)(lds + 131072 + 4096), tid};
                pg8::gemm_phase<pg8::EpiResid>(lds, g, S, E, tid);
            } else if (s == 2) {
                pg8::Gemm g{xb, (const bf16_t*)(ws + (layer == 0 ? WS_WMIX0 : WS_WMIX1)), T, ldz, DM};
                pg8::Order S; if (layer == 0) S.init(T, NMIX0, G, bx, 16, 4); else S.init(T, NMIX1, G, bx);
                pg8::EpiZ E{zb, ldz, layer, layer == 0 ? 7 : 10, ssq, memkv, p.in[16], p.in[17], p.in[8], p.in[9]};
                pg8::gemm_phase<pg8::EpiZ>(lds, g, S, E, tid);
            } else if (s == 3) {
            } else {
                float sb_mem, sb_diff = 0.f;
                { float a = fabsf(p.in[8][layer * 64 + lane]), b = fabsf(p.in[9][layer * 64 + lane]);
#pragma unroll
                  for (int o_ = 1; o_ < 64; o_ <<= 1) { a = fmaxf(a, __shfl_xor(a, o_)); b = fmaxf(b, __shfl_xor(b, o_)); }
                  sb_mem = __uint_as_float(__builtin_amdgcn_readfirstlane(__float_as_uint(64.f * C2 * a * b * 1.02f + 0.1f))); }
                if (layer == 1) { float a = fabsf(p.in[16][lane]), b = fabsf(p.in[17][lane]);
#pragma unroll
                  for (int o_ = 1; o_ < 64; o_ <<= 1) { a = fmaxf(a, __shfl_xor(a, o_)); b = fmaxf(b, __shfl_xor(b, o_)); }
                  sb_diff = __uint_as_float(__builtin_amdgcn_readfirstlane(__float_as_uint(64.f * C2 * a * b * 1.02f + 0.1f))); }
                const int vcu = (G % 8 == 0) ? (bx % 8) * (G / 8) + bx / 8 : bx;
                if (layer == 0) {
                    gmlp_phase(lds, zb, (const bf16_t*)(ws + WS_WSB), p.in[14], p.in[12], cat, vcu, G, tid);
                } else {
                    const float* lp = p.in[18];
                    const float sa = wave_sum(lp[lane] * lp[64 + lane]), sb = wave_sum(lp[128 + lane] * lp[192 + lane]);
                    const float lam = __uint_as_float(__builtin_amdgcn_readfirstlane(__float_as_uint(__expf(sa) - __expf(sb) + LAMBDA_INIT)));
#pragma unroll 1
                    for (int u = vcu; u < 1536; u += G) {
                        const int pi = u % 768, k = u / 768;
                        const int bh = pi >> 3, qlo = pi & 7, b = bh / 6, hh = bh % 6;
                        const int qb = k == 0 ? 15 - qlo : qlo; const size_t rb = (size_t)b * SEQ;
                        attn_unit<true>(lds, zb + (rb + qb * 128) * NMIX1 + hh * 128, NMIX1, zb + rb * NMIX1 + 768 + hh * 128, zb + rb * NMIX1 + 1536 + hh * 128, NMIX1,
                                        cat + (rb + qb * 128) * DM + hh * 128, qb, lam, p.in[19], sb_diff, tid);
                    }
                }
#pragma unroll 1
                for (int u = vcu; u < 512; u += G) {
                    const int b = u >> 5, pr = (u >> 4) & 1, qb = u & 15; const size_t rb = (size_t)b * SEQ;
                    attn_unit<false>(lds, zb + (rb + qb * 128) * ldz + qmoff + pr * 128, ldz, memkv + (size_t)b * MEML * DM + layer * 512 + pr * 128,
                                     memkv + (size_t)b * MEML * DM + layer * 512 + 256 + pr * 128, DM, cat + (rb + qb * 128) * DM + 768 + pr * 128, qb, 0.f, nullptr, sb_mem, tid);
                }
            }
        }
        if (phi + 1 < ph_hi) { if (phi == ph_lo) { grid.sync(); xbar = xcd_barrier_post(barw, bst, tid); } else xcd_barrier(xbar, tid); }
    }
}

extern "C" void kernel_launch(void* const* d_in, const int* in_sizes, int n_in, void* d_out, int out_size, void* d_ws, size_t ws_size, hipStream_t stream) {
    static int grid = 0;
    if (grid == 0) {
        if (n_in != 20 || out_size != T * DM || ws_size < WS_END) { fprintf(stderr, "kernel_launch: unexpected shapes (n_in %d, out %d, ws %zu, need %zu)\n", n_in, out_size, ws_size, (size_t)WS_END); grid = -1; return; }
        int dev = 0, cus = 0, per_cu = 0;
        (void)hipGetDevice(&dev);
        (void)hipDeviceGetAttribute(&cus, hipDeviceAttributeMultiprocessorCount, dev);
        if (hipFuncSetAttribute((const void*)fwd_megakernel, hipFuncAttributeMaxDynamicSharedMemorySize, LDS_BYTES) != hipSuccess) { fprintf(stderr, "kernel_launch: hipFuncSetAttribute failed\n"); grid = -1; return; }
        if (hipOccupancyMaxActiveBlocksPerMultiprocessor(&per_cu, (const void*)fwd_megakernel, 512, LDS_BYTES) != hipSuccess || per_cu < 1) { fprintf(stderr, "kernel_launch: occupancy query says %d\n", per_cu); per_cu = 1; }
        (void)hipGetLastError();
        grid = cus * 1;
        (void)per_cu;
    }
    if (grid < 0) return;
    Params p{};
    for (int i = 0; i < 20; ++i) p.in[i] = (const float*)d_in[i];
    p.out = (float*)d_out; p.ws = (unsigned char*)d_ws;
    int ph_lo = 0, ph_hi = N_PHASES;
    void* args[] = {&p, &ph_lo, &ph_hi};
    hipError_t e = hipLaunchCooperativeKernel((const void*)fwd_megakernel, dim3(grid), dim3(512), args, LDS_BYTES, stream);
    if (e != hipSuccess) fprintf(stderr, "cooperative launch failed: %s (grid %d)\n", hipGetErrorString(e), grid);
}
```

```cpp
#include <hip/hip_runtime.h>
#include <hip/hip_cooperative_groups.h>
#include <cstdio>
#include <cstdint>
namespace cg = cooperative_groups;

#define LAS __attribute__((address_space(3)))
typedef unsigned short bf16_t;
typedef short bf16x8 __attribute__((ext_vector_type(8)));
typedef short s16x4 __attribute__((ext_vector_type(4)));
typedef float f32x2 __attribute__((ext_vector_type(2)));
typedef float f32x4 __attribute__((ext_vector_type(4)));
typedef float f32x16 __attribute__((ext_vector_type(16)));
typedef unsigned u32x2 __attribute__((ext_vector_type(2)));
typedef unsigned u32x4 __attribute__((ext_vector_type(4)));
typedef __bf16 bf16x2_t __attribute__((ext_vector_type(2)));
typedef double d64x2 __attribute__((ext_vector_type(2)));

constexpr int T = 32768, DM = 1024, FF = 2816, SEQ = 2048, NB = 16, MEML = 256, MROWS = NB * MEML, AROWS = T + MROWS;
constexpr int NMIX0 = 1792, NMIX1 = 2560;
constexpr float EPS = 1e-6f;
constexpr float C2 = 0.125f * 1.4426950408889634f;
constexpr float LAMBDA_INIT = 0.35550906759f;

constexpr size_t MiB = 1u << 20;
constexpr size_t SZ_WFFIN = (size_t)2 * FF * DM * 2, SZ_WFFOUT = (size_t)DM * FF * 2;
constexpr size_t WS_WFFIN = 0;
constexpr size_t WS_WFFOUT = WS_WFFIN + 4 * SZ_WFFIN;
constexpr size_t WS_WMIX0 = WS_WFFOUT + 4 * SZ_WFFOUT;
constexpr size_t WS_WMIX1 = WS_WMIX0 + (size_t)2816 * DM * 2;
constexpr size_t WS_WO = WS_WMIX1 + (size_t)NMIX1 * DM * 2;
constexpr size_t WS_XB = WS_WO + (size_t)2 * DM * DM * 2;
constexpr size_t WS_ACT = WS_XB + (size_t)AROWS * DM * 2;
constexpr size_t WS_CAT = WS_ACT + (size_t)T * FF * 2;
constexpr size_t WS_MEMKV = WS_CAT + (size_t)T * DM * 2;
constexpr size_t WS_SSQ = WS_MEMKV + (size_t)MROWS * DM * 2;
constexpr size_t WS_BAR = WS_SSQ + (size_t)AROWS * 16 * 4;
constexpr size_t WS_WSB = WS_BAR + 16384;
constexpr size_t WS_END = WS_WSB + (size_t)6 * 128 * 128 * 2;

constexpr int LDS_BYTES = 147456;

__device__ __forceinline__ unsigned pk_bf16(float lo, float hi) { f32x2 v = {lo, hi}; bf16x2_t b = __builtin_convertvector(v, bf16x2_t); return __builtin_bit_cast(unsigned, b); }
__device__ __forceinline__ float bf_lo(unsigned u) { return __builtin_bit_cast(float, u << 16); }
__device__ __forceinline__ float bf_hi(unsigned u) { return __builtin_bit_cast(float, u & 0xffff0000u); }
__device__ __forceinline__ float wave_sum(float v) {
#pragma unroll
    for (int o = 1; o < 64; o <<= 1) v += __shfl_xor(v, o);
    return v;
}
__device__ __forceinline__ float fast_exp2(float x) { return __builtin_amdgcn_exp2f(x); }
__device__ __forceinline__ float fast_rcp(float x) { return __builtin_amdgcn_rcpf(x); }
__device__ __forceinline__ f32x2 gelu_pk(f32x2 v) {
    const f32x2 av = __builtin_elementwise_abs(v), d = av * 0.2316418882f + 1.0f;
    f32x2 t; t.x = __builtin_amdgcn_rcpf(d.x); t.y = __builtin_amdgcn_rcpf(d.y);
    f32x2 q = t * 0.5307027145f + (-0.7265760135f); q = q * t + 0.7107068705f; q = q * t + (-0.142248368f); q = q * t + 0.127414796f; q = q * t;
    const f32x2 s = (v * v) * (-0.72134752044f);
    f32x2 e; e.x = __builtin_amdgcn_exp2f(s.x); e.y = __builtin_amdgcn_exp2f(s.y);
    const f32x2 m = v * (q * e), r = v - m;
    f32x2 o; o.x = v.x < 0.f ? m.x : r.x; o.y = v.y < 0.f ? m.y : r.y; return o;
}
__device__ __forceinline__ f32x4 gelu4(f32x4 v) { f32x2 a = gelu_pk((f32x2){v[0], v[1]}), b = gelu_pk((f32x2){v[2], v[3]}); return (f32x4){a.x, a.y, b.x, b.y}; }
__device__ __forceinline__ float silu(float g) { return g * fast_rcp(1.f + fast_exp2(-1.4426950408889634f * g)); }
__device__ __forceinline__ float row_rstd(const float* ssq, int row) {
    const f32x4 s = *(const f32x4*)(ssq + (size_t)row * 4);
    return rsqrtf(((s.x + s.y) + (s.z + s.w)) * (1.f / DM) + EPS);
}

__device__ __forceinline__ void rstd_finish(const f32x4& raw0, const f32x4& raw1, float& rn0, float& rn1) {
    rn0 = rsqrtf(((raw0.x + raw0.y) + (raw0.z + raw0.w)) * (1.f / DM) + EPS); rn1 = rsqrtf(((raw1.x + raw1.y) + (raw1.z + raw1.w)) * (1.f / DM) + EPS);
    asm volatile("" :: "v"(rn0), "v"(rn1) : "memory");
}

namespace pg8 {
constexpr int BM = 256, BK = 64, HALF = 128, HTB = HALF * BK * 2, STAGE_BYTES = 8 * HTB, NXCD = 8, WGM = 8;
__host__ __device__ __forceinline__ int lds_byte(int r, int c) { const int st = (r >> 4) * 2 + (c >> 5), rr = r & 15, cc = c & 31, ob = rr * 64 + cc * 2; return st * 1024 + (ob ^ (((ob >> 9) & 1) << 5)); }
__host__ __device__ __forceinline__ void stage_rc(int b, int& R, int& C) { const int st = b / 1024, sb = b % 1024, swz = sb ^ (((sb >> 9) & 1) << 5); R = (st >> 1) * 16 + swz / 64; C = (st & 1) * 32 + (swz % 64) / 2; }
__host__ __device__ __forceinline__ int perm32(int rho) { const int n = rho >> 4, i = rho & 15; return 8 * (i >> 2) + 4 * n + (i & 3); }

struct Unit { int pm, pn; };
struct Gemm { const bf16_t* A; const bf16_t* Bt; int M, N, K; };

struct Order {
    int nM, nN, nwg, G, c, exM, total;
    __device__ void init(int M, int N, int G_, int c_, int exM_ = 0, int exN_ = 0) { nM = M / BM; nN = N / BM; nwg = nM * nN; G = G_; c = c_; exM = exM_; total = nwg + exM_ * exN_; }
    __device__ bool next(int i, Unit& u) const {
        const long L = (long)i * G + c; if (L >= total) return false;
        if (L >= nwg) { const int e = (int)L - nwg; u.pm = nM + e % exM; u.pn = nN + e / exM; return true; }
        int wgid = (int)L; { const int q = nwg / NXCD, r = nwg % NXCD, xcd = wgid % NXCD, off = wgid / NXCD; wgid = (xcd < r ? xcd * (q + 1) : r * (q + 1) + (xcd - r) * q) + off; }
        const int nig = WGM * nN, gid = wgid / nig, fm = gid * WGM, gsz = (nM - fm) < WGM ? (nM - fm) : WGM;
        u.pm = fm + ((wgid % nig) % gsz); u.pn = (wgid % nig) / gsz; return true;
    }
};


struct EpiSwiglu {
    static constexpr bool NEEDS_RSTD = true, EARLY_RSTD = true;
    bf16_t* O; const float* ssq;
    __device__ __forceinline__ void operator()(const f32x4 (&acc)[2][2][4][2], const Unit& u, int wr, int wc, int fr, int fq, float rp0, float rp1, const f32x4& raw0, const f32x4& raw1, float& rn0, float& rn1) const {
        const int row0 = u.pm * BM + wr * 64 + fr, col0 = u.pn * 128 + wc * 32 + 8 * fq;
        float rs[8];
#pragma unroll
        for (int k = 0; k < 8; ++k) rs[k] = __shfl((k >> 2) ? rp1 : rp0, fr + 16 * (k & 3));
#pragma unroll
        for (int ai = 0; ai < 2; ++ai)
#pragma unroll
            for (int m = 0; m < 4; ++m) {
                const int row = row0 + ai * HALF + m * 16; const float r = rs[ai * 4 + m];
                const float c1 = -1.4426950408889634f * r, r2 = r * r;
                const f32x4 ga = acc[ai][0][m][0], gb = acc[ai][0][m][1];
                const f32x4 ta = ga * c1, tb = gb * c1;
                f32x4 ea, eb;
#pragma unroll
                for (int j = 0; j < 4; ++j) { ea[j] = fast_exp2(ta[j]); eb[j] = fast_exp2(tb[j]); }
                const f32x4 da = ea + 1.f, db = eb + 1.f;
                f32x4 qa, qb;
#pragma unroll
                for (int j = 0; j < 4; ++j) { qa[j] = fast_rcp(da[j]); qb[j] = fast_rcp(db[j]); }
                const f32x4 oa = ((ga * acc[ai][1][m][0]) * r2) * qa, ob = ((gb * acc[ai][1][m][1]) * r2) * qb;
                u32x4 w;
                w.x = pk_bf16(oa[0], oa[1]); w.y = pk_bf16(oa[2], oa[3]); w.z = pk_bf16(ob[0], ob[1]); w.w = pk_bf16(ob[2], ob[3]);
                if (ai == 0 && m == 0) rstd_finish(raw0, raw1, rn0, rn1);
                *(u32x4*)(O + (size_t)row * FF + col0) = w;
            }
    }
};
struct EpiResid {
    static constexpr bool NEEDS_RSTD = false, EARLY_RSTD = false;
    bf16_t* xb; float* outf; float* ssq; float alpha; LAS float* red; int tid;
    __device__ __forceinline__ void operator()(const f32x4 (&acc)[2][2][4][2], const Unit& u, int wr, int wc, int fr, int fq, float, float, const f32x4&, const f32x4&, float&, float&) const {
        const int row0 = u.pm * BM + wr * 64 + fr, col0 = u.pn * BM + wc * 32 + 8 * fq;
        const size_t off0 = (size_t)row0 * DM + col0;
        u32x4 xv[3][2];
#define RESID_LOAD(slot, k) do { const bf16_t* _p = xb + off0 + (size_t)(((k) >> 2) * HALF + ((k) & 3) * 16) * DM; \
        xv[slot][0] = *(const u32x4*)(_p); xv[slot][1] = *(const u32x4*)(_p + HALF); } while (0)
        RESID_LOAD(0, 0); RESID_LOAD(1, 1);
#pragma unroll
        for (int k = 0; k < 8; ++k) {
            const int ai = k >> 2, m = k & 3;
            if (k + 2 < 8) RESID_LOAD((k + 2) % 3, k + 2);
            const size_t off = off0 + (size_t)(ai * HALF + m * 16) * DM; float sq = 0.f;
#pragma unroll
            for (int bj = 0; bj < 2; ++bj) {
                const u32x4 xr = xv[k % 3][bj];
                f32x4 x0 = {bf_lo(xr.x), bf_hi(xr.x), bf_lo(xr.y), bf_hi(xr.y)}, x1 = {bf_lo(xr.z), bf_hi(xr.z), bf_lo(xr.w), bf_hi(xr.w)};
                x0 = x0 + acc[ai][bj][m][0] * alpha; x1 = x1 + acc[ai][bj][m][1] * alpha;
                if (outf) { *(f32x4*)(outf + off + bj * HALF) = x0; *(f32x4*)(outf + off + bj * HALF + 4) = x1; }
                else {
                    u32x4 w; w.x = pk_bf16(x0[0], x0[1]); w.y = pk_bf16(x0[2], x0[3]); w.z = pk_bf16(x1[0], x1[1]); w.w = pk_bf16(x1[2], x1[3]);
                    *(u32x4*)(xb + off + bj * HALF) = w;
                    const f32x4 q = x0 * x0 + x1 * x1; sq += (q[0] + q[1]) + (q[2] + q[3]);
                }
            }
            if (!outf) {
                sq += __shfl_xor(sq, 16); sq += __shfl_xor(sq, 32);
                if (fq == 0) red[(ai * HALF + wr * 64 + m * 16 + fr) * 4 + wc] = sq;
            }
        }
#undef RESID_LOAD
        if (!outf) {
            __syncthreads();
            const int t = tid;
            if (t < BM) { const f32x4 s = *(const LAS f32x4*)(red + t * 4); ssq[(size_t)(u.pm * BM + t) * 4 + u.pn] = (s.x + s.y) + (s.z + s.w); }
        }
    }
};
struct EpiZ {
    static constexpr bool NEEDS_RSTD = true, EARLY_RSTD = false;
    bf16_t* Z; int ldz; int layer; int nmain; const float* ssq; bf16_t* KV; const float* gq; const float* gk; const float* gmq; const float* gmk;
    __device__ __forceinline__ void operator()(const f32x4 (&acc)[2][2][4][2], const Unit& u, int wr, int wc, int fr, int fq, float rp0, float rp1, const f32x4& raw0, const f32x4& raw1, float& rn0, float& rn1) const {
        const int arow0 = u.pm * BM + wr * 64 + fr, pn = u.pn;
        bf16_t* base; int ld;
        if (pn < nmain) { base = Z + (size_t)arow0 * ldz + pn * BM; ld = ldz; }
        else { base = KV + (size_t)(arow0 - T) * DM + (pn - nmain) * BM; ld = DM; }
        base += wc * 64 + 8 * fq;
        int mode = 0; const float* gain = gmq; float scale = 1.f;
        if (layer == 0) { if (pn < 6) mode = 1; else if (pn == 6) { mode = 2; scale = C2; } else if (pn == 7) { mode = 2; gain = gmk; } else if (pn == 9) { mode = 2; gain = gmk + 64; } }
        else { if (pn < 3) { mode = 2; gain = gq; scale = C2; } else if (pn < 6) { mode = 2; gain = gk; } else if (pn == 9) { mode = 2; gain = gmq + 64; scale = C2; } }
        if (mode == 2) {
            f32x4 g[2][2];
#pragma unroll
            for (int bj = 0; bj < 2; ++bj)
#pragma unroll
                for (int n = 0; n < 2; ++n) g[bj][n] = *(const f32x4*)(gain + bj * 32 + 8 * fq + 4 * n) * scale;
#pragma unroll
            for (int ai = 0; ai < 2; ++ai) {
                float rs[4];
#pragma unroll
                for (int k = 0; k < 4; ++k) rs[k] = __shfl(ai ? rp1 : rp0, fr + 16 * k);
#pragma unroll
                for (int m = 0; m < 4; ++m) {
                    const int roff = ai * HALF + m * 16; const float r = rs[m];
                    const f32x4 v00 = acc[ai][0][m][0] * r, v01 = acc[ai][0][m][1] * r, v10 = acc[ai][1][m][0] * r, v11 = acc[ai][1][m][1] * r;
                    const f32x4 sq4 = (v00 * v00 + v01 * v01) + (v10 * v10 + v11 * v11);
                    float ss = (sq4[0] + sq4[1]) + (sq4[2] + sq4[3]);
                    ss += __shfl_xor(ss, 16); ss += __shfl_xor(ss, 32);
                    const float rr = rsqrtf(ss * (1.f / 64.f) + EPS);
                    const f32x4 o00 = v00 * rr * g[0][0], o01 = v01 * rr * g[0][1], o10 = v10 * rr * g[1][0], o11 = v11 * rr * g[1][1];
                    u32x4 w0, w1;
                    w0.x = pk_bf16(o00[0], o00[1]); w0.y = pk_bf16(o00[2], o00[3]); w0.z = pk_bf16(o01[0], o01[1]); w0.w = pk_bf16(o01[2], o01[3]);
                    w1.x = pk_bf16(o10[0], o10[1]); w1.y = pk_bf16(o10[2], o10[3]); w1.z = pk_bf16(o11[0], o11[1]); w1.w = pk_bf16(o11[2], o11[3]);
                    *(u32x4*)(base + (size_t)roff * ld) = w0; *(u32x4*)(base + (size_t)roff * ld + 32) = w1;
                }
            }
        } else {
            const bool gel = mode == 1;
#pragma unroll
            for (int ai = 0; ai < 2; ++ai) {
                float rs[4];
#pragma unroll
                for (int k = 0; k < 4; ++k) rs[k] = __shfl(ai ? rp1 : rp0, fr + 16 * k);
#pragma unroll
                for (int m = 0; m < 4; ++m) {
                    const int roff = ai * HALF + m * 16; const float r = rs[m];
#pragma unroll
                    for (int bj = 0; bj < 2; ++bj) {
                        f32x4 v0 = acc[ai][bj][m][0] * r, v1 = acc[ai][bj][m][1] * r;
                        if (gel) { v0 = gelu4(v0); v1 = gelu4(v1); }
                        u32x4 w; w.x = pk_bf16(v0[0], v0[1]); w.y = pk_bf16(v0[2], v0[3]); w.z = pk_bf16(v1[0], v1[1]); w.w = pk_bf16(v1[2], v1[3]);
                        *(u32x4*)(base + (size_t)roff * ld + bj * 32) = w;
                    }
                }
            }
        }
    }
};

template <class Epi>
__device__ __forceinline__ void gemm_phase(LAS unsigned char* lds, const Gemm g, const Order& S, const Epi& E, const int tid) {
    const int wid = __builtin_amdgcn_readfirstlane(tid >> 6), lane = tid & 63, wr = wid >> 2, wc = wid & 3, fr = lane & 15, fq = lane >> 4;
    const int K = g.K, nt = K / BK;
    unsigned voffA[2], voffB[2];
#pragma unroll
    for (int i = 0; i < 2; ++i) { int R, C; stage_rc(tid * 16 + i * 8192, R, C); const int Rb = (R & ~31) + perm32(R & 31);
        voffA[i] = (unsigned)(R * K + C) * 2u; voffB[i] = (unsigned)(Rb * K + C) * 2u; }
    const size_t kstep = (size_t)(BK * 2);
    const size_t hstep = (size_t)HALF * K * 2;
    const size_t tstep = 2 * hstep;
    const unsigned ldsw = (unsigned)wid * 1024u;
    const int aoff = lds_byte(wr * 64 + fr, fq * 8), boff = lds_byte(wc * 32 + fr, fq * 8);
#define PG8_SA(b, h) (((b) * 2 + (h)) * HTB)
#define PG8_SB(b, h) ((4 + (b) * 2 + (h)) * HTB)
#define PG8_STAGE(bufoff, gbase, voff) do { _Pragma("unroll") for (int _i = 0; _i < 2; ++_i) \
        __builtin_amdgcn_global_load_lds((const unsigned*)((const char*)(gbase) + (voff)[_i]), (LAS unsigned*)(lds + (bufoff) + ldsw + _i * 8192), 16, 0, 0); } while (0)
#define PG8_LDA(dst, b, h) do { _Pragma("unroll") for (int m = 0; m < 4; ++m) _Pragma("unroll") for (int k = 0; k < 2; ++k) dst[m][k] = *(const LAS bf16x8*)(lds + PG8_SA(b, h) + aoff + m * 2048 + k * 1024); } while (0)
#define PG8_LDB(dst, b, h) do { _Pragma("unroll") for (int n = 0; n < 2; ++n) _Pragma("unroll") for (int k = 0; k < 2; ++k) dst[n][k] = *(const LAS bf16x8*)(lds + PG8_SB(b, h) + boff + n * 2048 + k * 1024); } while (0)
#define PG8_MMA(ai, bj, At, Bt) do { __builtin_amdgcn_s_setprio(1); _Pragma("unroll") for (int m = 0; m < 4; ++m) _Pragma("unroll") for (int n = 0; n < 2; ++n) _Pragma("unroll") for (int k = 0; k < 2; ++k) \
        acc[ai][bj][m][n] = __builtin_amdgcn_mfma_f32_16x16x32_bf16(Bt[n][k], At[m][k], acc[ai][bj][m][n], 0, 0, 0); __builtin_amdgcn_s_setprio(0); } while (0)
#define PG8_WAIT_V(n) asm volatile("s_waitcnt vmcnt(" #n ")" ::: "memory")
#define PG8_WAIT_L(n) asm volatile("s_waitcnt lgkmcnt(" #n ")" ::: "memory")
#define PG8_BAR __builtin_amdgcn_s_barrier()
#define PG8_SCHED __builtin_amdgcn_sched_barrier(0)
    Unit cur, nxt; int ui = 0;
    if (!S.next(0, cur)) return;
    float rp0 = 0.f, rp1 = 0.f;
    if constexpr (Epi::NEEDS_RSTD) { const int rr = cur.pm * BM + wr * 64 + fr + 16 * fq; rp0 = row_rstd(E.ssq, rr); rp1 = row_rstd(E.ssq, rr + HALF); }
    f32x4 acc[2][2][4][2];
#pragma unroll
    for (int a = 0; a < 2; ++a)
#pragma unroll
        for (int b = 0; b < 2; ++b)
#pragma unroll
            for (int m = 0; m < 4; ++m)
#pragma unroll
                for (int n = 0; n < 2; ++n) { double zl, zh; asm volatile("v_mov_b64 %0, 0\n\tv_mov_b64 %1, 0" : "=v"(zl), "=v"(zh)); d64x2 zz = {zl, zh}; acc[a][b][m][n] = __builtin_bit_cast(f32x4, zz); }
    bf16x8 At[4][2], B0[2][2], B1[2][2];
    const char* cA = (const char*)g.A + (size_t)cur.pm * tstep; const char* cB = (const char*)g.Bt + (size_t)cur.pn * tstep;
    PG8_STAGE(PG8_SB(0, 0), cB, voffB); PG8_STAGE(PG8_SB(0, 1), cB + hstep, voffB); PG8_STAGE(PG8_SA(0, 0), cA, voffA); PG8_STAGE(PG8_SA(0, 1), cA + hstep, voffA);
    if (wr == 1) PG8_BAR;
    PG8_WAIT_V(2); PG8_BAR;
    PG8_STAGE(PG8_SB(1, 0), cB + kstep, voffB); PG8_STAGE(PG8_SA(1, 0), cA + kstep, voffA); PG8_STAGE(PG8_SB(1, 1), cB + hstep + kstep, voffB);
    PG8_WAIT_V(6); PG8_BAR;
    for (;;) {
        const bool has_next = S.next(ui + 1, nxt);
        const char* nA = has_next ? (const char*)g.A + (size_t)nxt.pm * tstep : cA; const char* nB = has_next ? (const char*)g.Bt + (size_t)nxt.pn * tstep : cB;
        for (int t = 0; t < nt; t += 2) {
            const bool last = (t == nt - 2);
            const char* a1 = cA + (size_t)(t + 1) * kstep;
            const char* a2 = last ? nA : cA + (size_t)(t + 2) * kstep; const char* b2 = last ? nB : cB + (size_t)(t + 2) * kstep;
            const char* a3 = a2 + kstep; const char* b3 = b2 + kstep;
            PG8_LDB(B0, 0, 0); PG8_LDB(B1, 0, 1); PG8_SCHED; PG8_LDA(At, 0, 0); PG8_STAGE(PG8_SA(1, 1), a1 + hstep, voffA);
            PG8_WAIT_V(8); PG8_WAIT_L(0); PG8_BAR; PG8_MMA(0, 0, At, B0); PG8_MMA(0, 1, At, B1); PG8_BAR; PG8_SCHED;
            PG8_LDA(At, 0, 1); PG8_STAGE(PG8_SB(0, 0), b2, voffB); PG8_STAGE(PG8_SB(0, 1), b2 + hstep, voffB); PG8_STAGE(PG8_SA(0, 0), a2, voffA);
            PG8_WAIT_V(8); PG8_WAIT_L(0); PG8_BAR; PG8_MMA(1, 0, At, B0); PG8_MMA(1, 1, At, B1); PG8_BAR; PG8_SCHED;
            PG8_LDB(B0, 1, 0); PG8_LDB(B1, 1, 1); PG8_SCHED; PG8_LDA(At, 1, 0); PG8_STAGE(PG8_SA(0, 1), a2 + hstep, voffA);
            PG8_WAIT_V(8); PG8_WAIT_L(0); PG8_BAR; PG8_MMA(0, 0, At, B0); PG8_MMA(0, 1, At, B1); PG8_BAR; PG8_SCHED;
            PG8_LDA(At, 1, 1); PG8_STAGE(PG8_SB(1, 0), b3, voffB); PG8_STAGE(PG8_SB(1, 1), b3 + hstep, voffB); PG8_STAGE(PG8_SA(1, 0), a3, voffA);
            PG8_WAIT_V(8); PG8_WAIT_L(0); PG8_BAR; PG8_MMA(1, 0, At, B0); PG8_MMA(1, 1, At, B1); PG8_BAR; PG8_SCHED;
        }
        f32x4 raw0, raw1;
        if constexpr (Epi::NEEDS_RSTD) { const int rr = (has_next ? nxt.pm : cur.pm) * BM + wr * 64 + fr + 16 * fq;
            raw0 = *(const f32x4*)(E.ssq + (size_t)rr * 4); raw1 = *(const f32x4*)(E.ssq + (size_t)(rr + HALF) * 4); }
        if (wr == 0) PG8_BAR;
        float rn0 = 0.f, rn1 = 0.f;
        E(acc, cur, wr, wc, fr, fq, rp0, rp1, raw0, raw1, rn0, rn1);
        if constexpr (Epi::NEEDS_RSTD && !Epi::EARLY_RSTD) rstd_finish(raw0, raw1, rn0, rn1);
        rp0 = rn0; rp1 = rn1;
        if (!has_next) break;
#pragma unroll
        for (int a = 0; a < 2; ++a)
#pragma unroll
            for (int b = 0; b < 2; ++b)
#pragma unroll
                for (int m = 0; m < 4; ++m)
#pragma unroll
                    for (int n = 0; n < 2; ++n) { double zl, zh; asm volatile("v_mov_b64 %0, 0\n\tv_mov_b64 %1, 0" : "=v"(zl), "=v"(zh)); d64x2 zz = {zl, zh}; acc[a][b][m][n] = __builtin_bit_cast(f32x4, zz); }
        cur = nxt; cA = nA; cB = nB; ++ui;
        if (wr == 1) PG8_BAR;
    }
    PG8_WAIT_V(0);
    PG8_BAR;
#undef PG8_SA
#undef PG8_SB
#undef PG8_STAGE
#undef PG8_LDA
#undef PG8_LDB
#undef PG8_MMA
#undef PG8_WAIT_V
#undef PG8_WAIT_L
#undef PG8_BAR
#undef PG8_SCHED
}
}

struct TrDesc { const float* W; int K, N; bf16_t* WT; const float* gain; int k0, n0, drow0; };
__device__ __forceinline__ void tr_loads(const TrDesc& d, float (&wv)[32], int lane) {
#pragma unroll
    for (int i = 0; i < 32; ++i) wv[i] = d.W[(size_t)(d.k0 + 2 * i + (lane >> 5)) * d.N + d.n0 + (lane & 31)];
}
__device__ __forceinline__ void tr_finish(const TrDesc& d, float (&wv)[32], LAS float* scr, int lane) {
    if (d.gain) {
#pragma unroll
        for (int i = 0; i < 32; ++i) wv[i] *= d.gain[d.k0 + 2 * i + (lane >> 5)];
    }
#pragma unroll
    for (int i = 0; i < 32; ++i) scr[(2 * i + (lane >> 5)) * 33 + (lane & 31)] = wv[i];
    asm volatile("s_waitcnt lgkmcnt(0)" ::: "memory");
    const int c = lane & 7;
#pragma unroll
    for (int j = 0; j < 4; ++j) { const int n = (lane >> 3) + 8 * j; const LAS float* s = scr + (8 * c) * 33 + n;
        u32x4 o; o.x = pk_bf16(s[0 * 33], s[1 * 33]); o.y = pk_bf16(s[2 * 33], s[3 * 33]); o.z = pk_bf16(s[4 * 33], s[5 * 33]); o.w = pk_bf16(s[6 * 33], s[7 * 33]);
        *(u32x4*)(d.WT + (size_t)(d.drow0 + n) * d.K + d.k0 + 8 * c) = o; }
    asm volatile("s_waitcnt lgkmcnt(0)" ::: "memory");
}
__device__ __forceinline__ void row_to_bf16(const float* xrow, bf16_t* orow, float* ssqrow, int lane) {
    const f32x4* xr = (const f32x4*)xrow + lane;
    f32x4 v[4]; float s = 0.f;
#pragma unroll
    for (int j = 0; j < 4; ++j) { v[j] = xr[64 * j]; s += (v[j].x * v[j].x + v[j].y * v[j].y) + (v[j].z * v[j].z + v[j].w * v[j].w); }
    s = wave_sum(s);
    u32x2* o8 = (u32x2*)orow + lane;
#pragma unroll
    for (int j = 0; j < 4; ++j) { u32x2 w; w.x = pk_bf16(v[j].x, v[j].y); w.y = pk_bf16(v[j].z, v[j].w); o8[64 * j] = w; }
    if (lane < 16) ssqrow[lane] = lane == 0 ? s : 0.f;
}

struct Params { const float* in[20]; float* out; unsigned char* ws; };
__device__ __forceinline__ int mixrow(int n0) { const int l = n0 & 255; return (n0 & ~255) + ((l >> 5) & 1) * 128 + (l >> 6) * 32; }

__device__ __forceinline__ void prologue(const Params& p, LAS unsigned char* lds, int gw, int NGW, int wave, int lane) {
    LAS float* scr = (LAS float*)(lds + wave * 16384);
    unsigned char* ws = p.ws;
    constexpr int I_FFIN = 16 * 176, I_FFOUT = 44 * 32, I_MIX0 = 16 * 56, I_KV = 16 * 16, I_MIX1 = 16 * 80, I_WO = 16 * 32;
    constexpr int C0 = 4 * I_FFIN, C1 = C0 + 4 * I_FFOUT, C2_ = C1 + I_MIX0, C3 = C2_ + 2 * I_KV, C4 = C3 + I_MIX1, C5 = C4 + 2 * I_WO;
    for (int it0 = gw; it0 < C5; it0 += 2 * NGW) {
        TrDesc ds[2];
#pragma unroll
        for (int q = 0; q < 2; ++q) {
            const int it = min(it0 + q * NGW, C5 - 1); TrDesc& d = ds[q];
            if (it < C0) {
                const int mat = it / I_FFIN, r = it % I_FFIN, kb = r / 176, nb = r % 176, n0 = nb * 32;
                const int j = n0 < FF ? n0 : n0 - FF; const int drow0 = (j >> 7) * 256 + (n0 < FF ? 0 : 128) + (j & 127);
                d = TrDesc{p.in[3] + (size_t)mat * DM * 2 * FF, DM, 2 * FF, (bf16_t*)(ws + WS_WFFIN + mat * SZ_WFFIN), p.in[2] + mat * DM, kb * 64, n0, drow0};
            } else if (it < C1) {
                const int r0 = it - C0, mat = r0 / I_FFOUT, r = r0 % I_FFOUT, kb = r / 32, nb = r % 32;
                d = TrDesc{p.in[4] + (size_t)mat * FF * DM, FF, DM, (bf16_t*)(ws + WS_WFFOUT + mat * SZ_WFFOUT), nullptr, kb * 64, nb * 32, nb * 32};
            } else if (it < C2_) {
                const int r = it - C1, kb = r / 56, nb = r % 56;
                d = TrDesc{p.in[11], DM, NMIX0, (bf16_t*)(ws + WS_WMIX0), p.in[5], kb * 64, nb * 32, mixrow(nb * 32)};
            } else if (it < C3) {
                const int r0 = it - C2_, l = r0 / I_KV, r = r0 % I_KV, kb = r / 16, nb = r % 16;
                d = TrDesc{p.in[7] + (size_t)l * DM * 512, DM, 512, (bf16_t*)(ws + WS_WMIX0), p.in[6] + l * DM, kb * 64, nb * 32, NMIX0 + l * 512 + mixrow(nb * 32)};
            } else if (it < C4) {
                const int r = it - C3, kb = r / 80, nb = r % 80;
                d = TrDesc{p.in[15], DM, NMIX1, (bf16_t*)(ws + WS_WMIX1), p.in[5] + DM, kb * 64, nb * 32, mixrow(nb * 32)};
            } else {
                const int r0 = it - C4, l = r0 / I_WO, r = r0 % I_WO, kb = r / 32, nb = r % 32;
                d = TrDesc{p.in[10] + (size_t)l * DM * DM, DM, DM, (bf16_t*)(ws + WS_WO + (size_t)l * DM * DM * 2), nullptr, kb * 64, nb * 32, nb * 32};
            }
        }
        float wa[32], wb[32];
        tr_loads(ds[0], wa, lane); tr_loads(ds[1], wb, lane);
        tr_finish(ds[0], wa, scr, lane); tr_finish(ds[1], wb, scr, lane);
    }
    {
        const int gt = gw * 64 + lane;
        if (gt < 6 * 128 * 16) {
            const int row = gt >> 4, seg = gt & 15, t = row & 127;
            const float* s = p.in[13] + (size_t)row * 128 + seg * 8;
            f32x4 a = *(const f32x4*)s, b = *(const f32x4*)(s + 4);
#pragma unroll
            for (int j = 0; j < 4; ++j) { if (seg * 8 + j > t) a[j] = 0.f; if (seg * 8 + 4 + j > t) b[j] = 0.f; }
            u32x4 o; o.x = pk_bf16(a[0], a[1]); o.y = pk_bf16(a[2], a[3]); o.z = pk_bf16(b[0], b[1]); o.w = pk_bf16(b[2], b[3]);
            *(u32x4*)((bf16_t*)(ws + WS_WSB) + (size_t)row * 128 + seg * 8) = o;
        }
    }
    bf16_t* xb = (bf16_t*)(ws + WS_XB); float* ssq = (float*)(ws + WS_SSQ);
    for (int m = gw; m < AROWS; m += 2 * NGW) {
        const int m2 = m + NGW; const bool two = m2 < AROWS;
        const float* s1 = m < T ? p.in[0] + (size_t)m * DM : p.in[1] + (size_t)(m - T) * DM;
        const float* s2 = !two ? s1 : (m2 < T ? p.in[0] + (size_t)m2 * DM : p.in[1] + (size_t)(m2 - T) * DM);
        const f32x4* x1 = (const f32x4*)s1 + lane; const f32x4* x2 = (const f32x4*)s2 + lane;
        f32x4 a[4], b[4];
#pragma unroll
        for (int j = 0; j < 4; ++j) { a[j] = x1[64 * j]; b[j] = x2[64 * j]; }
        float sa = 0.f, sb = 0.f;
#pragma unroll
        for (int j = 0; j < 4; ++j) { sa += (a[j].x * a[j].x + a[j].y * a[j].y) + (a[j].z * a[j].z + a[j].w * a[j].w); sb += (b[j].x * b[j].x + b[j].y * b[j].y) + (b[j].z * b[j].z + b[j].w * b[j].w); }
        sa = wave_sum(sa); sb = wave_sum(sb);
        u32x2* o1 = (u32x2*)(xb + (size_t)m * DM) + lane;
#pragma unroll
        for (int j = 0; j < 4; ++j) { u32x2 w; w.x = pk_bf16(a[j].x, a[j].y); w.y = pk_bf16(a[j].z, a[j].w); o1[64 * j] = w; }
        if (lane < 4) ssq[(size_t)m * 4 + lane] = lane == 0 ? sa : 0.f;
        if (two) {
            u32x2* o2 = (u32x2*)(xb + (size_t)m2 * DM) + lane;
#pragma unroll
            for (int j = 0; j < 4; ++j) { u32x2 w; w.x = pk_bf16(b[j].x, b[j].y); w.y = pk_bf16(b[j].z, b[j].w); o2[64 * j] = w; }
            if (lane < 4) ssq[(size_t)m2 * 4 + lane] = lane == 0 ? sb : 0.f;
        }
    }
}

#define MFMA32(a, b, c) __builtin_amdgcn_mfma_f32_32x32x16_bf16((a), (b), (c), 0, 0, 0)
__device__ __forceinline__ bf16x8 vtr8(LAS const char* p, int hi_off) {
    const s16x4 lo = __builtin_amdgcn_ds_read_tr16_b64_v4i16((LAS s16x4*)p);
    const s16x4 hi = __builtin_amdgcn_ds_read_tr16_b64_v4i16((LAS s16x4*)(p + hi_off));
    return __builtin_shufflevector(lo, hi, 0, 1, 2, 3, 4, 5, 6, 7);
}
__device__ __forceinline__ bf16x8 pack8(const f32x16& x, int s) {
    u32x4 p; p.x = pk_bf16(x[8 * s], x[8 * s + 1]); p.y = pk_bf16(x[8 * s + 2], x[8 * s + 3]); p.z = pk_bf16(x[8 * s + 4], x[8 * s + 5]); p.w = pk_bf16(x[8 * s + 6], x[8 * s + 7]);
    return __builtin_bit_cast(bf16x8, p);
}
constexpr int ATT_KP = 272, ATT_VP = 320, ATT_KBUF = 64 * ATT_KP, ATT_VBUF = 64 * ATT_VP, ATT_VOFF = 2 * ATT_KBUF;

__device__ __forceinline__ float xor32_max(float m) {
    auto rr = __builtin_amdgcn_permlane32_swap(__float_as_uint(m), __float_as_uint(m), false, false);
    return fmaxf(__uint_as_float(rr[0]), __uint_as_float(rr[1]));
}
__device__ __forceinline__ float xor32_sum(float m) {
    auto rr = __builtin_amdgcn_permlane32_swap(__float_as_uint(m), __float_as_uint(m), false, false);
    return __uint_as_float(rr[0]) + __uint_as_float(rr[1]);
}
template <bool DIFF, int NDV>
__device__ __forceinline__ void attn_tile(f32x16 (&o)[NDV], float& l, const bf16x8 (&qf)[4], const float sref, LAS const char* kc, LAS const char* vc,
                                          bool masked, int kb0, int qrow) {
    bf16x8 kf[8];
#pragma unroll
    for (int ks = 0; ks < 4; ++ks) { kf[2 * ks] = *(LAS const bf16x8*)(kc + ks * 32); kf[2 * ks + 1] = *(LAS const bf16x8*)(kc + 32 * ATT_KP + ks * 32); }
    f32x16 s0, s1;
#pragma unroll
    for (int i = 0; i < 16; ++i) { s0[i] = 0.f; s1[i] = 0.f; }
#pragma unroll
    for (int ks = 0; ks < 4; ++ks) { s0 = MFMA32(kf[2 * ks], qf[ks], s0); s1 = MFMA32(kf[2 * ks + 1], qf[ks], s1); }
    __builtin_amdgcn_sched_barrier(0);
    bf16x8 vf[8];
#pragma unroll
    for (int d = 0; d < 2; ++d)
#pragma unroll
        for (int kk = 0; kk < 4; ++kk) vf[d * 4 + kk] = vtr8(vc + kk * 16 * ATT_VP + d * 64, 8 * ATT_VP);
    __builtin_amdgcn_sched_barrier(0);
    if (DIFF && masked) {
#pragma unroll
        for (int i = 0; i < 16; ++i) { const int key = kb0 + (i & 3) + 8 * (i >> 2); if (key > qrow) s0[i] = -1e30f; if (key + 32 > qrow) s1[i] = -1e30f; }
    }
    if (sref != 0.f) {
#pragma unroll
        for (int i = 0; i < 16; ++i) { s0[i] -= sref; s1[i] -= sref; }
    }
    float rs = 0.f;
#pragma unroll
    for (int i = 0; i < 16; ++i) { s0[i] = fast_exp2(s0[i]); s1[i] = fast_exp2(s1[i]); rs += s0[i] + s1[i]; }
    l += rs;
    bf16x8 pb[4];
    pb[0] = pack8(s0, 0); pb[1] = pack8(s0, 1); pb[2] = pack8(s1, 0); pb[3] = pack8(s1, 1);
    if (NDV == 4) {
        bf16x8 vf2[8];
#pragma unroll
        for (int d = 0; d < 2; ++d)
#pragma unroll
            for (int kk = 0; kk < 4; ++kk) vf2[d * 4 + kk] = vtr8(vc + kk * 16 * ATT_VP + (d + 2) * 64, 8 * ATT_VP);
        __builtin_amdgcn_sched_barrier(0);
#pragma unroll
        for (int kk = 0; kk < 4; ++kk) { o[0] = MFMA32(vf[kk], pb[kk], o[0]); o[1] = MFMA32(vf[4 + kk], pb[kk], o[1]); }
#pragma unroll
        for (int kk = 0; kk < 4; ++kk) { o[2] = MFMA32(vf2[kk], pb[kk], o[2]); o[NDV - 1] = MFMA32(vf2[4 + kk], pb[kk], o[NDV - 1]); }
    } else {
#pragma unroll
        for (int kk = 0; kk < 4; ++kk) { o[0] = MFMA32(vf[kk], pb[kk], o[0]); o[1] = MFMA32(vf[4 + kk], pb[kk], o[1]); }
    }
}

template <bool DIFF>
__device__ __forceinline__ void attn_unit(LAS unsigned char* lds, const bf16_t* Qp, int ldq, const bf16_t* Kp, const bf16_t* Vp, int ldkv,
                                          bf16_t* Op, int qb, float lam, const float* subln, const float sbound, const int tid) {
    constexpr int NDV = DIFF ? 4 : 2;
    const int w = __builtin_amdgcn_readfirstlane(tid >> 6), lane = tid & 63, r = lane & 31, h = lane >> 5, c = w >> 2, sq = w & 3;
    const int nkt = DIFF ? 2 * qb + 2 : 4;
    const int my_last = DIFF ? ((qb * 128 + sq * 32 + 31) >> 6) : 3;
    const int qrow = qb * 128 + sq * 32 + r;
    bf16x8 qf[4];
    { const bf16_t* qptr = Qp + (size_t)(sq * 32 + r) * ldq + c * 64 + 8 * h;
#pragma unroll
      for (int ks = 0; ks < 4; ++ks) qf[ks] = *(const bf16x8*)(qptr + 16 * ks); }
    const int srow = tid >> 3, sseg = tid & 7;
    const bf16_t* kg = Kp + (size_t)srow * ldkv + sseg * 16;
    const bf16_t* vg = Vp + (size_t)srow * ldkv + sseg * 16;
    const size_t g64 = (size_t)64 * ldkv;
    LAS unsigned char* kw = lds + srow * ATT_KP + sseg * 32;
    LAS unsigned char* vw = lds + ATT_VOFF + srow * ATT_VP + sseg * 32;
    u32x4 ra[4], rb[4];
#define ATT_LOAD(R, kti) do { const bf16_t* _k = kg + (size_t)(kti) * g64; const bf16_t* _v = vg + (size_t)(kti) * g64; \
        R[0] = *(const u32x4*)_k; R[1] = *(const u32x4*)(_k + 8); R[2] = *(const u32x4*)_v; R[3] = *(const u32x4*)(_v + 8); } while (0)
#define ATT_WRITE(R, buf) do { LAS unsigned char* _k = kw + (buf) * ATT_KBUF; LAS unsigned char* _v = vw + (buf) * ATT_VBUF; \
        *(LAS u32x4*)_k = R[0]; *(LAS u32x4*)(_k + 16) = R[1]; *(LAS u32x4*)_v = R[2]; *(LAS u32x4*)(_v + 16) = R[3]; } while (0)
    ATT_LOAD(ra, 0);
    ATT_LOAD(rb, 1);
    ATT_WRITE(ra, 0);
    f32x16 o[NDV];
#pragma unroll
    for (int d = 0; d < NDV; ++d)
#pragma unroll
        for (int i = 0; i < 16; ++i) o[d][i] = 0.f;
    float l = 0.f;
    const float sref = fmaxf(sbound - 64.f, 0.f);
    asm volatile("" :: "v"(qf[0]), "v"(qf[1]), "v"(qf[2]), "v"(qf[3]));
    __syncthreads();
    LAS const char* kb = (LAS const char*)lds + r * ATT_KP + (c * 64 + 8 * h) * 2;
    const int q4 = (lane & 15) >> 2, p4 = lane & 3, blk = (lane >> 4) & 1;
    LAS const char* vb = (LAS const char*)lds + ATT_VOFF + (4 * h + q4) * ATT_VP + ((DIFF ? 0 : c * 64) + 16 * blk) * 2 + 8 * p4;
    const int q0w = qb * 128 + sq * 32;
    typedef __attribute__((address_space(1))) const char* gcptr; typedef __attribute__((address_space(1))) const u32x4* gvptr;
    unsigned long long pa = (unsigned long long)(kg + (size_t)min(2, nkt - 1) * g64);
    asm volatile("" : "+v"(pa));
    const long kvd = (long)((const char*)Vp - (const char*)Kp);
#define ATT_STEP(kti, LD, WR) do { \
        LD[0] = *(gvptr)(gcptr)pa; LD[1] = *(gvptr)((gcptr)pa + 16); LD[2] = *(gvptr)((gcptr)pa + kvd); LD[3] = *(gvptr)((gcptr)pa + kvd + 16);     \
        pa = (unsigned long long)(kg + (size_t)min((kti) + 3, nkt - 1) * g64); asm volatile("" : "+v"(pa)); \
        if ((kti) <= my_last) attn_tile<DIFF, NDV>(o, l, qf, sref, kb + ((kti) & 1) * ATT_KBUF, vb + ((kti) & 1) * ATT_VBUF, (kti) * 64 + 63 > q0w, (kti) * 64 + 4 * h, qrow); \
        if ((kti) + 1 < nkt) ATT_WRITE(WR, ((kti) + 1) & 1); \
        __syncthreads(); } while (0)
#pragma unroll 1
    for (int kt = 0; kt < nkt; kt += 2) {
        ATT_STEP(kt, ra, rb);
        ATT_STEP(kt + 1, rb, ra);
    }
#undef ATT_STEP
#undef ATT_LOAD
#undef ATT_WRITE
    l = xor32_sum(l);
    const float inv = 1.f / l;
    if (!DIFF) {
        bf16_t* orow = Op + (size_t)(sq * 32 + r) * DM + c * 64 + 4 * h;
#pragma unroll
        for (int d = 0; d < NDV; ++d)
#pragma unroll
            for (int g = 0; g < 4; ++g) {
                u32x2 wv; wv.x = pk_bf16(o[d][4 * g] * inv, o[d][4 * g + 1] * inv); wv.y = pk_bf16(o[d][4 * g + 2] * inv, o[d][4 * g + 3] * inv);
                *(u32x2*)(orow + d * 32 + 8 * g) = wv;
            }
    } else {
        LAS float* ex = (LAS float*)lds + sq * 4096 + lane;
        f32x4 gn[16];
        if (c == 0) {
#pragma unroll
            for (int d = 0; d < NDV; ++d)
#pragma unroll
                for (int g = 0; g < 4; ++g) gn[d * 4 + g] = *(const f32x4*)(subln + d * 32 + 8 * g + 4 * h);
        }
        if (c == 1) {
            const float sc = lam * inv;
#pragma unroll
            for (int d = 0; d < NDV; ++d)
#pragma unroll
                for (int i = 0; i < 16; ++i) ex[(d * 16 + i) * 64] = o[d][i] * sc;
        }
        __syncthreads();
        if (c == 0) {
            float ss = 0.f;
#pragma unroll
            for (int d = 0; d < NDV; ++d)
#pragma unroll
                for (int i = 0; i < 16; ++i) { const float v = o[d][i] * inv - ex[(d * 16 + i) * 64]; o[d][i] = v; ss += v * v; }
            ss = xor32_sum(ss);
            const float rr = rsqrtf(ss * (1.f / 128.f) + EPS) * (1.f - LAMBDA_INIT);
            bf16_t* orow = Op + (size_t)(sq * 32 + r) * DM + 4 * h;
#pragma unroll
            for (int d = 0; d < NDV; ++d)
#pragma unroll
                for (int g = 0; g < 4; ++g) {
                    const f32x4 gv = gn[d * 4 + g];
                    u32x2 wv; wv.x = pk_bf16(o[d][4 * g] * rr * gv[0], o[d][4 * g + 1] * rr * gv[1]); wv.y = pk_bf16(o[d][4 * g + 2] * rr * gv[2], o[d][4 * g + 3] * rr * gv[3]);
                    *(u32x2*)(orow + d * 32 + 8 * g) = wv;
                }
        }
        __syncthreads();
    }
}

struct GmlpRegs { u32x4 v[4]; u32x2 uv[8]; u32x4 w[8]; float bias; };
__device__ __forceinline__ void gmlp_load(GmlpRegs& R, const bf16_t* zb, const bf16_t* wsb, const float* bsall, int u, int tid, int t, int h, int cb0) {
    const int b = u / 96, rem = u % 96, n = rem / 6, g = rem % 6;
    const bf16_t* zrows = zb + ((size_t)b * SEQ + n * 128) * NMIX0;
    const bf16_t* urow = zrows + (size_t)t * NMIX0 + g * 128 + 4 * h;
#pragma unroll
    for (int i = 0; i < 8; ++i) R.uv[i] = *(const u32x2*)(urow + (cb0 + (i >> 2)) * 32 + 8 * (i & 3));
    const bf16_t* wrow = wsb + (size_t)g * 128 * 128 + (size_t)t * 128 + 8 * h;
#pragma unroll
    for (int i = 0; i < 8; ++i) R.w[i] = *(const u32x4*)(wrow + 16 * i);
    R.bias = bsall[g * 128 + t];
    const bf16_t* vgp = zrows + (size_t)(tid >> 2) * NMIX0 + 768 + g * 128 + (tid & 3) * 32;
#pragma unroll
    for (int j = 0; j < 4; ++j) R.v[j] = *(const u32x4*)(vgp + 8 * j);
}
__device__ __forceinline__ void gmlp_compute(LAS unsigned char* lds, const GmlpRegs& R, bf16_t* cat, int u, int tid, int lane, int t, int h, int cb0) {
    constexpr int VP = 320, GOFF = 49152;
    const int b = u / 96, rem = u % 96, n = rem / 6, g = rem % 6;
    {
        const int row = tid >> 2, qtr = tid & 3;
        float ss = 0.f;
#pragma unroll
        for (int j = 0; j < 4; ++j)
#pragma unroll
            for (int e = 0; e < 4; ++e) { const float x = bf_lo(R.v[j][e]), y = bf_hi(R.v[j][e]); ss += x * x + y * y; }
        ss += __shfl_xor(ss, 1); ss += __shfl_xor(ss, 2);
        const float rs = rsqrtf(ss * (1.f / 128.f) + EPS);
        LAS const unsigned char* gp = lds + GOFF + (g * 128 + qtr * 32) * 4;
        LAS unsigned char* dst = lds + row * VP + qtr * 64;
#pragma unroll
        for (int j = 0; j < 4; ++j) {
            const f32x4 g0 = *(LAS const f32x4*)(gp + 32 * j), g1 = *(LAS const f32x4*)(gp + 32 * j + 16);
            u32x4 o;
            o.x = pk_bf16(bf_lo(R.v[j].x) * rs * g0[0], bf_hi(R.v[j].x) * rs * g0[1]); o.y = pk_bf16(bf_lo(R.v[j].y) * rs * g0[2], bf_hi(R.v[j].y) * rs * g0[3]);
            o.z = pk_bf16(bf_lo(R.v[j].z) * rs * g1[0], bf_hi(R.v[j].z) * rs * g1[1]); o.w = pk_bf16(bf_lo(R.v[j].w) * rs * g1[2], bf_hi(R.v[j].w) * rs * g1[3]);
            *(LAS u32x4*)(dst + 16 * j) = o;
        }
    }
    __syncthreads();
    const int q4 = (lane & 15) >> 2, p4 = lane & 3, blk = (lane >> 4) & 1;
    LAS const char* vb = (LAS const char*)lds + (8 * h + q4) * VP + (cb0 * 32 + 16 * blk) * 2 + 8 * p4;
    f32x16 a0, a1;
#pragma unroll
    for (int i = 0; i < 16; ++i) { a0[i] = 0.f; a1[i] = 0.f; }
#pragma unroll
    for (int ks = 0; ks < 8; ++ks) {
        const bf16x8 wf = __builtin_bit_cast(bf16x8, R.w[ks]);
        const bf16x8 v0 = vtr8(vb + ks * 16 * VP, 4 * VP), v1 = vtr8(vb + ks * 16 * VP + 64, 4 * VP);
        a0 = MFMA32(v0, wf, a0); a1 = MFMA32(v1, wf, a1);
    }
    bf16_t* orow = cat + ((size_t)b * SEQ + n * 128 + t) * DM + g * 128 + 4 * h;
    const float bias = R.bias;
#pragma unroll
    for (int cbi = 0; cbi < 2; ++cbi)
#pragma unroll
        for (int gq = 0; gq < 4; ++gq) {
            const int c0 = (cb0 + cbi) * 32 + 8 * gq;
            const u32x2 uu = R.uv[cbi * 4 + gq];
            const f32x16& a = cbi ? a1 : a0;
            u32x2 wv; wv.x = pk_bf16(bf_lo(uu.x) * (a[4 * gq] + bias), bf_hi(uu.x) * (a[4 * gq + 1] + bias));
            wv.y = pk_bf16(bf_lo(uu.y) * (a[4 * gq + 2] + bias), bf_hi(uu.y) * (a[4 * gq + 3] + bias));
            *(u32x2*)(orow + c0) = wv;
        }
    __syncthreads();
}
__device__ __forceinline__ void gmlp_phase(LAS unsigned char* lds, const bf16_t* zb, const bf16_t* wsb, const float* bsall, const float* vgall, bf16_t* cat, int vcu, int G, const int tid) {
    constexpr int GOFF = 49152;
    if (vcu >= 1536) return;
    if (tid < 192) *(LAS f32x4*)(lds + GOFF + tid * 16) = *(const f32x4*)(vgall + tid * 4);
    const int w = __builtin_amdgcn_readfirstlane(tid >> 6), lane = tid & 63, r = lane & 31, h = lane >> 5;
    const int tb = w & 3, cb0 = (w >> 2) * 2; int t = 32 * tb + r; asm volatile("" : "+v"(t));
    int u = vcu;
    GmlpRegs A; gmlp_load(A, zb, wsb, bsall, u, tid, t, h, cb0);
    __syncthreads();
#pragma unroll 1
    for (;;) {
        const int un = u + G; const bool hn = un < 1536;
        GmlpRegs B; gmlp_load(B, zb, wsb, bsall, hn ? un : u, tid, t, h, cb0);
        gmlp_compute(lds, A, cat, u, tid, lane, t, h, cb0);
        if (!hn) break;
        A = B; u = un;
    }
}

#define XB_TMO      128
#define XB_XCNT(j)  (256  + 64 * (j))
#define XB_XSUB(j)  (1280 + 64 * (j))
#define XB_XGEN(j)  (2304 + 64 * (j))
#define XB_TOP      3328
#define XB_TOPGEN   3392
#define XCD_BAR_WORDS 3456
#define XB_SPIN_CAP (1u << 20)
__device__ __forceinline__ unsigned xb_ld(unsigned* p)              { return __hip_atomic_load(p, __ATOMIC_RELAXED, __HIP_MEMORY_SCOPE_AGENT); }
__device__ __forceinline__ unsigned xb_add(unsigned* p, unsigned v) { return __hip_atomic_fetch_add(p, v, __ATOMIC_RELAXED, __HIP_MEMORY_SCOPE_AGENT); }
__device__ __forceinline__ unsigned xb_xcc_id() { return (unsigned)__builtin_amdgcn_s_getreg((3 << 11) | 20) & 0xFu; }
#define XB_SPIN(cond, bar) do { unsigned _sp = 0; while (cond) { __builtin_amdgcn_s_sleep(1); \
    if ((++_sp & 255u) == 0u) { if (xb_ld(&(bar)[XB_TMO])) break; if (_sp > XB_SPIN_CAP) { atomicAdd(&(bar)[XB_TMO], 1u); break; } } } } while (0)
struct XcdBarrier { unsigned* bar; unsigned x; volatile LAS unsigned* st; };
__device__ __forceinline__ XcdBarrier xcd_barrier_post(unsigned* bar, volatile LAS unsigned* st, const int tid) {
    XcdBarrier b; b.bar = bar; b.x = xb_xcc_id(); b.st = st;
    if (tid == 0) (void)xb_add(&bar[XB_XCNT(b.x)], 1u);
    return b;
}
__device__ __forceinline__ void xcd_barrier_complete(unsigned* bar, unsigned x, unsigned& nloc, unsigned& nx) {
    const unsigned G = gridDim.x * gridDim.y * gridDim.z;
    unsigned sum, cnt, mine, sp = 0u;
    for (;;) {
        sum = 0u; cnt = 0u; mine = 0u;
#pragma unroll
        for (unsigned j = 0; j < 16; ++j) { const unsigned c = xb_ld(&bar[XB_XCNT(j)]); sum += c; cnt += (c > 0u) ? 1u : 0u; mine = (j == x) ? c : mine; }
        if (sum == G) break;
        __builtin_amdgcn_s_sleep(1);
        if ((++sp & 255u) == 0u) { if (xb_ld(&bar[XB_TMO])) break; if (sp > XB_SPIN_CAP) { atomicAdd(&bar[XB_TMO], 1u); break; } }
    }
    nloc = mine > 0u ? mine : 1u; nx = cnt > 0u ? cnt : 1u;
}
__device__ __forceinline__ void xcd_barrier(const XcdBarrier& b, const int tid) {
    asm volatile("s_waitcnt vmcnt(0)" ::: "memory");
    __syncthreads();
    if (tid == 0) {
        unsigned* bar = b.bar;
        __builtin_amdgcn_s_waitcnt(0);
        unsigned nloc = b.st[0], nx = b.st[1];
        if (nloc == 0u) { xcd_barrier_complete(bar, b.x, nloc, nx); b.st[0] = nloc; b.st[1] = nx; }
        const unsigned old = xb_add(&bar[XB_XSUB(b.x)], 1u);
        const unsigned gen = old / nloc;
        if (old + 1u == (gen + 1u) * nloc) {
            __builtin_amdgcn_fence(__ATOMIC_RELEASE, "agent");
            asm volatile("s_waitcnt vmcnt(0)" ::: "memory");
            const unsigned og = xb_add(&bar[XB_TOP], 1u);
            const unsigned tg = og / nx;
            if (og + 1u == (tg + 1u) * nx) xb_add(&bar[XB_TOPGEN], 1u);
            else XB_SPIN(xb_ld(&bar[XB_TOPGEN]) == tg, bar);
            __builtin_amdgcn_fence(__ATOMIC_ACQUIRE, "agent");
            xb_add(&bar[XB_XGEN(b.x)], 1u);
            asm volatile("s_waitcnt vmcnt(0)" ::: "memory");
        } else {
            XB_SPIN(xb_ld(&bar[XB_XGEN(b.x)]) == gen, bar);
            __builtin_amdgcn_fence(__ATOMIC_ACQUIRE, "agent");
            asm volatile("s_waitcnt vmcnt(0)" ::: "memory");
        }
    }
    __syncthreads();
}

#define PHASE_SEQ 0, 1, 2, 3, 5, 6, 7, 8, 9, 10, 11, 13, 14, 15, 16
__constant__ unsigned char phase_seq[] = {PHASE_SEQ};
constexpr int N_PHASES = sizeof(phase_seq);
__global__ void __launch_bounds__(512, 2) fwd_megakernel(Params p_, int ph_lo, int ph_hi) {
    extern __shared__ __attribute__((aligned(16))) unsigned char lds_raw[];
    LAS unsigned char* lds = (LAS unsigned char*)lds_raw;
    cg::grid_group grid = cg::this_grid();
    volatile LAS unsigned* bst = (volatile LAS unsigned*)(lds + 131072 + 512);
    if (threadIdx.x < 2) bst[threadIdx.x] = 0u;
    unsigned* barw = (unsigned*)(p_.ws + WS_BAR);
    if (blockIdx.x == 0) for (int i = threadIdx.x; i < XCD_BAR_WORDS; i += 512) barw[i] = 0u;
    XcdBarrier xbar; xbar.bar = barw; xbar.x = 0; xbar.st = bst;
#pragma unroll 1
    for (int phi = ph_lo; phi < ph_hi; ++phi) {
        const int ph = phase_seq[phi];
        int tid = threadIdx.x; asm volatile("" : "+v"(tid));
        unsigned long long kab = (unsigned long long)__builtin_amdgcn_kernarg_segment_ptr(); asm volatile("" : "+s"(kab));
        const Params& p = *(const Params*)(const __attribute__((address_space(4))) char*)kab;
        const int lane = tid & 63, wave = __builtin_amdgcn_readfirstlane(tid >> 6);
        int G = gridDim.x, bx = blockIdx.x; asm volatile("" : "+s"(G), "+s"(bx));
        unsigned char* ws = p.ws;
        bf16_t* xb = (bf16_t*)(ws + WS_XB); bf16_t* act = (bf16_t*)(ws + WS_ACT); bf16_t* zb = act; bf16_t* cat = (bf16_t*)(ws + WS_CAT);
        bf16_t* memkv = (bf16_t*)(ws + WS_MEMKV); float* ssq = (float*)(ws + WS_SSQ);
        float* X = p.out;
        if (ph == 0) {
            prologue(p, lds, bx * 8 + wave, G * 8, wave, lane);
        } else if (ph < 17) {
            const int q = ph - 1, layer = q >> 3, s = q & 7;
            const int ldz = layer == 0 ? NMIX0 : NMIX1, qmoff = layer == 0 ? 1536 : 2304;
            if (s == 0 || s == 6) {
                const int mat = layer * 2 + (s == 6);
                pg8::Gemm g{xb, (const bf16_t*)(ws + WS_WFFIN + mat * SZ_WFFIN), T, 2 * FF, DM};
                pg8::Order S; S.init(T, 2 * FF, G, bx);
                pg8::EpiSwiglu E{act, ssq};
                pg8::gemm_phase<pg8::EpiSwiglu>(lds, g, S, E, tid);
            } else if (s == 1 || s == 7 || s == 5) {
                const int mat = layer * 2 + (s == 7);
                const bool op = s == 5;
                pg8::Gemm g{op ? cat : act, (const bf16_t*)(ws + (op ? WS_WO + (size_t)layer * DM * DM * 2 : WS_WFFOUT + mat * SZ_WFFOUT)), T, DM, op ? DM : FF};
                pg8::Order S; S.init(T, DM, G, bx);
                pg8::EpiResid E{xb, ph == 16 ? X : nullptr, ssq, op ? 1.f : 0.5f, (LAS float*)(lds + 131072 + 4096), tid};
                pg8::gemm_phase<pg8::EpiResid>(lds, g, S, E, tid);
            } else if (s == 2) {
                pg8::Gemm g{xb, (const bf16_t*)(ws + (layer == 0 ? WS_WMIX0 : WS_WMIX1)), T, ldz, DM};
                pg8::Order S; if (layer == 0) S.init(T, NMIX0, G, bx, 16, 4); else S.init(T, NMIX1, G, bx);
                pg8::EpiZ E{zb, ldz, layer, layer == 0 ? 7 : 10, ssq, memkv, p.in[16], p.in[17], p.in[8], p.in[9]};
                pg8::gemm_phase<pg8::EpiZ>(lds, g, S, E, tid);
            } else if (s == 3) {
            } else {
                float sb_mem, sb_diff = 0.f;
                { float a = fabsf(p.in[8][layer * 64 + lane]), b = fabsf(p.in[9][layer * 64 + lane]);
#pragma unroll
                  for (int o_ = 1; o_ < 64; o_ <<= 1) { a = fmaxf(a, __shfl_xor(a, o_)); b = fmaxf(b, __shfl_xor(b, o_)); }
                  sb_mem = __uint_as_float(__builtin_amdgcn_readfirstlane(__float_as_uint(64.f * C2 * a * b * 1.02f + 0.1f))); }
                if (layer == 1) { float a = fabsf(p.in[16][lane]), b = fabsf(p.in[17][lane]);
#pragma unroll
                  for (int o_ = 1; o_ < 64; o_ <<= 1) { a = fmaxf(a, __shfl_xor(a, o_)); b = fmaxf(b, __shfl_xor(b, o_)); }
                  sb_diff = __uint_as_float(__builtin_amdgcn_readfirstlane(__float_as_uint(64.f * C2 * a * b * 1.02f + 0.1f))); }
                const int vcu = (G % 8 == 0) ? (bx % 8) * (G / 8) + bx / 8 : bx;
                if (layer == 0) {
                    gmlp_phase(lds, zb, (const bf16_t*)(ws + WS_WSB), p.in[14], p.in[12], cat, vcu, G, tid);
                } else {
                    const float* lp = p.in[18];
                    const float sa = wave_sum(lp[lane] * lp[64 + lane]), sb = wave_sum(lp[128 + lane] * lp[192 + lane]);
                    const float lam = __uint_as_float(__builtin_amdgcn_readfirstlane(__float_as_uint(__expf(sa) - __expf(sb) + LAMBDA_INIT)));
#pragma unroll 1
                    for (int u = vcu; u < 1536; u += G) {
                        const int pi = u % 768, k = u / 768;
                        const int bh = pi >> 3, qlo = pi & 7, b = bh / 6, hh = bh % 6;
                        const int qb = k == 0 ? 15 - qlo : qlo; const size_t rb = (size_t)b * SEQ;
                        attn_unit<true>(lds, zb + (rb + qb * 128) * NMIX1 + hh * 128, NMIX1, zb + rb * NMIX1 + 768 + hh * 128, zb + rb * NMIX1 + 1536 + hh * 128, NMIX1,
                                        cat + (rb + qb * 128) * DM + hh * 128, qb, lam, p.in[19], sb_diff, tid);
                    }
                }
#pragma unroll 1
                for (int u = vcu; u < 512; u += G) {
                    const int b = u >> 5, pr = (u >> 4) & 1, qb = u & 15; const size_t rb = (size_t)b * SEQ;
                    attn_unit<false>(lds, zb + (rb + qb * 128) * ldz + qmoff + pr * 128, ldz, memkv + (size_t)b * MEML * DM + layer * 512 + pr * 128,
                                     memkv + (size_t)b * MEML * DM + layer * 512 + 256 + pr * 128, DM, cat + (rb + qb * 128) * DM + 768 + pr * 128, qb, 0.f, nullptr, sb_mem, tid);
                }
            }
        }
        if (phi + 1 < ph_hi) { if (phi == ph_lo) { grid.sync(); xbar = xcd_barrier_post(barw, bst, tid); } else xcd_barrier(xbar, tid); }
    }
}

extern "C" void kernel_launch(void* const* d_in, const int* in_sizes, int n_in, void* d_out, int out_size, void* d_ws, size_t ws_size, hipStream_t stream) {
    static int grid = 0;
    if (grid == 0) {
        if (n_in != 20 || out_size != T * DM || ws_size < WS_END) { fprintf(stderr, "kernel_launch: unexpected shapes (n_in %d, out %d, ws %zu, need %zu)\n", n_in, out_size, ws_size, (size_t)WS_END); grid = -1; return; }
        int dev = 0, cus = 0, per_cu = 0;
        (void)hipGetDevice(&dev);
        (void)hipDeviceGetAttribute(&cus, hipDeviceAttributeMultiprocessorCount, dev);
        if (hipFuncSetAttribute((const void*)fwd_megakernel, hipFuncAttributeMaxDynamicSharedMemorySize, LDS_BYTES) != hipSuccess) { fprintf(stderr, "kernel_launch: hipFuncSetAttribute failed\n"); grid = -1; return; }
        if (hipOccupancyMaxActiveBlocksPerMultiprocessor(&per_cu, (const void*)fwd_megakernel, 512, LDS_BYTES) != hipSuccess || per_cu < 1) { fprintf(stderr, "kernel_launch: occupancy query says %d\n", per_cu); per_cu = 1; }
        (void)hipGetLastError();
        grid = cus * 1;
        (void)per_cu;
    }
    if (grid < 0) return;
    Params p{};
    for (int i = 0; i < 20; ++i) p.in[i] = (const float*)d_in[i];
    p.out = (float*)d_out; p.ws = (unsigned char*)d_ws;
    int ph_lo = 0, ph_hi = N_PHASES;
    void* args[] = {&p, &ph_lo, &ph_hi};
    hipError_t e = hipLaunchCooperativeKernel((const void*)fwd_megakernel, dim3(grid), dim3(512), args, LDS_BYTES, stream);
    if (e != hipSuccess) fprintf(stderr, "cooperative launch failed: %s (grid %d)\n", hipGetErrorString(e), grid);
}
```
